# Optimizing an MI355X kernel written in HIP

```python
import math, functools
import jax, jax.numpy as jnp
from jax import lax
import numpy as np

D_MODEL = 1024
BATCH = 16
SEQ = 2048
DEPTH = 1
DEC_BATCH = 128
DEC_SEQ = 8
PAST_LEN = 16384
PAGE_SIZE = 128

HEAD_DIM = 64
N_HEADS = 8
N_KV = 2
GROUP = N_HEADS // N_KV
WINDOW = 128
BLOCK = WINDOW
Q_W = N_HEADS * HEAD_DIM
KV_W = N_KV * HEAD_DIM
N_BUCKETS = 32
MAX_EXACT = N_BUCKETS // 2
REL_MAX_DIST = 128
RW_N = 64
RW_HEADS = 8
RW = RW_HEADS * RW_N
LORA_W = 64
LORA_A = 64
LORA_G = 128
RW_SHIFT = 3 * RW + LORA_W + LORA_A + LORA_G
GATE_W = 2 * D_MODEL
IN_COLS = Q_W + 2 * KV_W + RW_SHIFT + GATE_W
D_FF = 2816
CONV_W = 3
NORM_EPS = 1e-6
GN_EPS = 64e-5
NEG = -1e30

kernel_name = 'swa_rwkv7_gated_hybrid_step'


def rmsnorm(x, g):
    xf = x.astype(jnp.float32)
    xf = xf * lax.rsqrt(jnp.mean(xf * xf, axis=-1, keepdims=True) + NORM_EPS)
    return (xf * g.astype(jnp.float32)).astype(x.dtype)


def t5_bucket(dist):
    n = jnp.maximum(dist, 0)
    nf = jnp.maximum(n, 1).astype(jnp.float32)
    large = MAX_EXACT + (jnp.log(nf / MAX_EXACT) / math.log(REL_MAX_DIST / MAX_EXACT)
                         * (N_BUCKETS - MAX_EXACT)).astype(jnp.int32)
    return jnp.where(n < MAX_EXACT, n, jnp.minimum(large, N_BUCKETS - 1))


def attend(q, k, v, dist, valid, rel_bias, sinks):
    s = jnp.einsum('...qhgd,...khd->...hgqk', q, k).astype(jnp.float32) * (HEAD_DIM ** -0.5)
    bias = rel_bias[t5_bucket(dist)].astype(jnp.float32)
    bias = jnp.transpose(bias, (2, 0, 1)).reshape(N_KV, GROUP, dist.shape[0], dist.shape[1])
    s = jnp.where(valid, s + bias, NEG)
    sink = jnp.broadcast_to(sinks.astype(jnp.float32).reshape(N_KV, GROUP, 1, 1), s.shape[:-1] + (1,))
    p = jax.nn.softmax(jnp.concatenate([s, sink], axis=-1), axis=-1)[..., :-1]
    return jnp.einsum('...hgqk,...khd->...qhgd', p.astype(v.dtype), v)


def banded_attention(q, k, v, rel_bias, sinks, win_buf):
    B, T = q.shape[:2]
    nb = T // BLOCK
    qb = q.reshape(B, nb, BLOCK, N_KV, GROUP, HEAD_DIM)
    kb = k.reshape(B, nb, BLOCK, N_KV, HEAD_DIM)
    vb = v.reshape(B, nb, BLOCK, N_KV, HEAD_DIM)

    def with_prev(t):
        prev = jnp.pad(t, ((0, 0), (1, 0), (0, 0), (0, 0), (0, 0)))[:, :-1]
        return jnp.concatenate([prev, t], axis=2)

    kc, vc = with_prev(kb), with_prev(vb)
    qi = jnp.arange(BLOCK) + BLOCK
    kj = jnp.arange(2 * BLOCK)
    dist = qi[:, None] - kj[None, :]
    key_abs = jnp.arange(nb)[:, None] * BLOCK - BLOCK + kj[None, :]
    valid = ((dist >= 0) & (dist < WINDOW))[None] & (key_abs >= 0)[:, None, :]
    o = attend(qb, kc, vc, dist, valid[:, None, None], rel_bias, sinks)
    return o.reshape(B, T, Q_W), k[:, T - win_buf:], v[:, T - win_buf:]


def window_cache_attention(q, k, v, cache_k, cache_v, rel_bias, sinks):
    B, T = q.shape[:2]
    wb = cache_k.shape[1]
    kc = jnp.concatenate([cache_k.astype(k.dtype), k], axis=1)
    vc = jnp.concatenate([cache_v.astype(v.dtype), v], axis=1)
    q_pos = PAST_LEN + jnp.arange(T)
    k_pos = jnp.concatenate([PAST_LEN - wb + jnp.arange(wb), PAST_LEN + jnp.arange(T)])
    dist = q_pos[:, None] - k_pos[None, :]
    valid = (dist >= 0) & (dist < WINDOW)
    o = attend(q, kc, vc, dist, valid, rel_bias, sinks)
    return o.reshape(B, T, Q_W), kc[:, T:], vc[:, T:]


def wkv_scan(r, w, k, v, av, bv, s0):
    def step(S, inp):
        r_t, w_t, k_t, v_t, a_t, b_t = inp
        sa = jnp.einsum('bhij,bhj->bhi', S, a_t)
        S = S * w_t[:, :, None, :] + sa[..., None] * b_t[:, :, None, :] + v_t[..., None] * k_t[:, :, None, :]
        return S, jnp.einsum('bhij,bhj->bhi', S, r_t)

    xs = tuple(jnp.moveaxis(t, 1, 0) for t in (r, w, k, v, av, bv))
    s_fin, ys = lax.scan(step, s0, xs)
    return jnp.moveaxis(ys, 0, 1), s_fin


def rwkv7_mixer(p, shift0, wkv0, mu_shift, w0, w2, a0, a2, g2, k_k, k_a, r_k, lnx_g, lnx_b):
    B, T, _ = p.shape
    f32 = jnp.float32
    prev = jnp.concatenate([shift0[:, None, :].astype(p.dtype), p[:, :-1]], axis=1)
    xs = p + mu_shift * (prev - p)
    r, k, v, lw, la, lg = jnp.split(xs, [RW, 2 * RW, 3 * RW, 3 * RW + LORA_W, 3 * RW + LORA_W + LORA_A], axis=-1)
    w_log = -jax.nn.softplus(-(w0 + jnp.tanh(lw) @ w2).astype(f32)) - 0.5
    decay = jnp.exp(-jnp.exp(w_log))
    a = jax.nn.sigmoid((a0 + la @ a2).astype(f32))
    g = jax.nn.sigmoid(lg) @ g2

    def hs(t):
        return t.astype(f32).reshape(B, T, RW_HEADS, RW_N)

    r, k, v, decay, a = hs(r), hs(k), hs(v), hs(decay), hs(a)
    kk = k * k_k.astype(f32).reshape(RW_HEADS, RW_N)
    kk = kk / jnp.maximum(jnp.sqrt(jnp.sum(kk * kk, axis=-1, keepdims=True)), 1e-12)
    k = k * (1.0 + (a - 1.0) * k_a.astype(f32).reshape(RW_HEADS, RW_N))
    y, s_new = wkv_scan(r, decay, k, v, -kk, kk * a, wkv0.astype(f32))
    mean = jnp.mean(y, axis=-1, keepdims=True)
    var = jnp.mean(jnp.square(y - mean), axis=-1, keepdims=True)
    y = (y - mean) * lax.rsqrt(var + GN_EPS)
    y = y * lnx_g.astype(f32).reshape(RW_HEADS, RW_N) + lnx_b.astype(f32).reshape(RW_HEADS, RW_N)
    y = y + jnp.sum(r * k * r_k.astype(f32), axis=-1, keepdims=True) * v
    out = y.reshape(B, T, RW).astype(p.dtype) * g
    return out, p[:, -1], s_new


def conv_ffn(h, conv0, w_up, conv_w, conv_b, w_down):
    T = h.shape[1]
    ug, uv = jnp.split(h @ w_up, 2, axis=-1)
    ucat = jnp.concatenate([conv0.astype(ug.dtype), ug], axis=1)
    c = conv_b
    for j in range(CONV_W):
        c = c + conv_w[j] * ucat[:, j:j + T]
    y = (jax.nn.gelu(c) * uv) @ w_down
    return y, ucat[:, T:]


def layer_forward(x, attn_fn, shift0, wkv0, conv0, norm1_g, w_in, mu_shift, w0, w2, a0, a2, g2,
                  k_k, k_a, r_k, lnx_g, lnx_b, w_pa, w_pb, w_o, norm2_g, w_up, conv_w, conv_b, w_down):
    B, T, _ = x.shape
    h = rmsnorm(x, norm1_g)
    proj = h @ w_in
    q, ka, va, rw, gates = jnp.split(proj, [Q_W, Q_W + KV_W, Q_W + 2 * KV_W, Q_W + 2 * KV_W + RW_SHIFT], axis=-1)
    q = q.reshape(B, T, N_KV, GROUP, HEAD_DIM)
    ka = ka.reshape(B, T, N_KV, HEAD_DIM)
    va = va.reshape(B, T, N_KV, HEAD_DIM)
    att, k_rows, v_rows = attn_fn(q, ka, va)
    rw_out, shift_new, wkv_new = rwkv7_mixer(rw, shift0, wkv0, mu_shift, w0, w2, a0, a2, g2,
                                             k_k, k_a, r_k, lnx_g, lnx_b)
    g_a, g_b = jnp.split(jax.nn.sigmoid(gates), 2, axis=-1)
    x = x + (g_a * (att @ w_pa) + g_b * (rw_out @ w_pb)) @ w_o
    y_ffn, conv_new = conv_ffn(rmsnorm(x, norm2_g), conv0, w_up, conv_w, conv_b, w_down)
    x = x + y_ffn
    return x, (k_rows, v_rows, shift_new, wkv_new, conv_new)


def setup_inputs(seed: int = 0) -> dict:
    key = jax.random.key(seed)
    ks = jax.random.split(key, 40)
    f32 = jnp.float32

    def nrm(k, shape, scale):
        return jax.random.normal(k, shape, f32) * scale

    wb = min(WINDOW, PAST_LEN)
    L = DEPTH
    return {
        'x_prompt': nrm(ks[0], (BATCH, SEQ, D_MODEL), 1.0),
        'x_sample': nrm(ks[1], (DEC_BATCH, DEC_SEQ, D_MODEL), 1.0),
        'cache_win_k': nrm(ks[2], (L, DEC_BATCH, wb, N_KV, HEAD_DIM), 1.0),
        'cache_win_v': nrm(ks[3], (L, DEC_BATCH, wb, N_KV, HEAD_DIM), 1.0),
        'state_shift': nrm(ks[4], (L, DEC_BATCH, RW_SHIFT), 1.0),
        'state_wkv': nrm(ks[5], (L, DEC_BATCH, RW_HEADS, RW_N, RW_N), 0.3),
        'state_conv': nrm(ks[6], (L, DEC_BATCH, CONV_W - 1, D_FF), 1.0),
        'rel_bias': nrm(ks[7], (N_BUCKETS, N_HEADS), 0.5),
        'norm1_g': 1.0 + nrm(ks[8], (L, D_MODEL), 0.05),
        'w_in': nrm(ks[9], (L, D_MODEL, IN_COLS), D_MODEL ** -0.5),
        'sinks': nrm(ks[10], (L, N_HEADS), 0.5),
        'mu_shift': jax.random.uniform(ks[11], (L, RW_SHIFT), f32),
        'w0': jax.random.uniform(ks[12], (L, RW), f32, -6.0, -1.0),
        'w2': nrm(ks[13], (L, LORA_W, RW), 0.5 * LORA_W ** -0.5),
        'a0': nrm(ks[14], (L, RW), 0.05),
        'a2': nrm(ks[15], (L, LORA_A, RW), LORA_A ** -0.5),
        'g2': nrm(ks[16], (L, LORA_G, RW), LORA_G ** -0.5),
        'k_k': 0.85 + nrm(ks[17], (L, RW), 0.05),
        'k_a': 1.0 + nrm(ks[18], (L, RW), 0.05),
        'r_k': nrm(ks[19], (L, RW_HEADS, RW_N), 0.1),
        'lnx_g': 1.0 + nrm(ks[20], (L, RW), 0.05),
        'lnx_b': nrm(ks[21], (L, RW), 0.02),
        'w_pa': nrm(ks[22], (L, Q_W, D_MODEL), Q_W ** -0.5),
        'w_pb': nrm(ks[23], (L, RW, D_MODEL), RW ** -0.5),
        'w_o': nrm(ks[24], (L, D_MODEL, D_MODEL), D_MODEL ** -0.5),
        'norm2_g': 1.0 + nrm(ks[25], (L, D_MODEL), 0.05),
        'w_up': nrm(ks[26], (L, D_MODEL, 2 * D_FF), D_MODEL ** -0.5),
        'conv_w': nrm(ks[27], (L, CONV_W, D_FF), CONV_W ** -0.5),
        'conv_b': nrm(ks[28], (L, D_FF), 0.02),
        'w_down': nrm(ks[29], (L, D_FF, D_MODEL), D_FF ** -0.5),
        'final_g': 1.0 + nrm(ks[30], (D_MODEL,), 0.05),
    }


def reference(x_prompt, x_sample, cache_win_k, cache_win_v, state_shift, state_wkv, state_conv,
              rel_bias, norm1_g, w_in, sinks, mu_shift, w0, w2, a0, a2, g2, k_k, k_a, r_k,
              lnx_g, lnx_b, w_pa, w_pb, w_o, norm2_g, w_up, conv_w, conv_b, w_down, final_g):
    xp, xs = x_prompt, x_sample
    bp = xp.shape[0]
    win_buf = cache_win_k.shape[2]
    pk, pv, psh, pwkv, pconv = [], [], [], [], []
    sk, sv, ssh, swkv, sconv = [], [], [], [], []
    for l in range(DEPTH):
        weights = (norm1_g[l], w_in[l], mu_shift[l], w0[l], w2[l], a0[l], a2[l], g2[l], k_k[l], k_a[l],
                   r_k[l], lnx_g[l], lnx_b[l], w_pa[l], w_pb[l], w_o[l], norm2_g[l], w_up[l], conv_w[l],
                   conv_b[l], w_down[l])
        prompt_attn = functools.partial(banded_attention, rel_bias=rel_bias, sinks=sinks[l], win_buf=win_buf)
        sample_attn = functools.partial(window_cache_attention, cache_k=cache_win_k[l], cache_v=cache_win_v[l],
                                        rel_bias=rel_bias, sinks=sinks[l])
        xp, st_p = layer_forward(xp, prompt_attn,
                                 jnp.zeros((bp, RW_SHIFT), xp.dtype),
                                 jnp.zeros((bp, RW_HEADS, RW_N, RW_N), jnp.float32),
                                 jnp.zeros((bp, CONV_W - 1, D_FF), xp.dtype),
                                 *weights)
        xs, st_s = layer_forward(xs, sample_attn, state_shift[l], state_wkv[l], state_conv[l], *weights)
        pk.append(st_p[0]); pv.append(st_p[1]); psh.append(st_p[2]); pwkv.append(st_p[3]); pconv.append(st_p[4])
        sk.append(st_s[0]); sv.append(st_s[1]); ssh.append(st_s[2]); swkv.append(st_s[3]); sconv.append(st_s[4])
    y_prompt = rmsnorm(xp, final_g)
    y_sample = rmsnorm(xs, final_g)
    p_win_k = jnp.stack(pk); p_win_v = jnp.stack(pv); p_shift = jnp.stack(psh)
    p_wkv = jnp.stack(pwkv); p_conv = jnp.stack(pconv)
    s_win_k = jnp.stack(sk); s_win_v = jnp.stack(sv); s_shift = jnp.stack(ssh)
    s_wkv = jnp.stack(swkv); s_conv = jnp.stack(sconv)
    return (y_prompt, y_sample, p_win_k, p_win_v, p_shift, p_wkv, p_conv, s_win_k, s_win_v, s_shift, s_wkv, s_conv)
```

```cpp
#include <hip/hip_runtime.h>
#include <cstdio>
#include <cstdint>
#include <cmath>
namespace pg8 {
#define PG8_LAS __attribute__((address_space(3)))
typedef unsigned short bf16_t;
typedef short bf16x8 __attribute__((ext_vector_type(8)));
typedef float f32x4 __attribute__((ext_vector_type(4)));
typedef unsigned u32x4 __attribute__((ext_vector_type(4)));
constexpr int BM = 256, BK = 64, HALF = 128, HTB = HALF * BK * 2  , STAGE_BYTES = 8 * HTB, NXCD = 8, WGM = 8;

__host__ __device__ __forceinline__ int lds_byte(int r, int c) { const int st = (r >> 4) * 2 + (c >> 5), rr = r & 15, cc = c & 31, ob = rr * 64 + cc * 2; return st * 1024 + (ob ^ (((ob >> 9) & 1) << 5)); }
__host__ __device__ __forceinline__ void stage_rc(int b, int& R, int& C) { const int st = b / 1024, sb = b % 1024, swz = sb ^ (((sb >> 9) & 1) << 5); R = (st >> 1) * 16 + swz / 64; C = (st & 1) * 32 + (swz % 64) / 2; }
__host__ __device__ __forceinline__ int perm32(int rho) { const int n = rho >> 4, i = rho & 15; return 8 * (i >> 2) + 4 * n + (i & 3); }

struct Unit { int pm, pn; };
struct Gemm { const bf16_t* A; const bf16_t* Bt; int M, N, K; int lda, ldb; int bhalf_rows, btile_rows; };

struct StaticOrder {
    int nM, nN, nwg, G, c;
    __host__ __device__ void init(int M, int N, int G_, int c_) { nM = M / BM; nN = N / BM; nwg = nM * nN; G = G_; c = c_; }
    __host__ __device__ bool next(int i, Unit& u) const {
        const long L = (long)i * G + c; if (L >= nwg) return false;
        int wgid = (int)L; { const int q = nwg / NXCD, r = nwg % NXCD, xcd = wgid % NXCD, off = wgid / NXCD; wgid = (xcd < r ? xcd * (q + 1) : r * (q + 1) + (xcd - r) * q) + off; }
        const int nig = WGM * nN, gid = wgid / nig, fm = gid * WGM, gsz = (nM - fm) < WGM ? (nM - fm) : WGM;
        u.pm = fm + ((wgid % nig) % gsz); u.pn = (wgid % nig) / gsz; return true;
    }
    __device__ __forceinline__ void a_ready(const Unit&) const {}
    __device__ __forceinline__ void done(const Unit&) const {}
};

__device__ __forceinline__ unsigned cvt_pk_bf16(float lo, float hi) { unsigned r; asm volatile("v_cvt_pk_bf16_f32 %0, %1, %2" : "=v"(r) : "v"(lo), "v"(hi)); return r; }
__device__ __forceinline__ float bflo(unsigned w) { return __builtin_bit_cast(float, w << 16); }
__device__ __forceinline__ float bfhi(unsigned w) { return __builtin_bit_cast(float, w & 0xffff0000u); }
__device__ __forceinline__ float sigmoidf_fast(float x) { return __builtin_amdgcn_rcpf(1.0f + __builtin_amdgcn_exp2f(-1.4426950408889634f * x)); }
__device__ __forceinline__ u32x4 pack8(const f32x4& v0, const f32x4& v1) { u32x4 w; w.x = cvt_pk_bf16(v0[0], v0[1]); w.y = cvt_pk_bf16(v0[2], v0[3]); w.z = cvt_pk_bf16(v1[0], v1[1]); w.w = cvt_pk_bf16(v1[2], v1[3]); return w; }

struct EpiProj {
    static constexpr bool PERM = true, AFTER_DRAIN = false;
    bf16_t *qkv, *rwb, *ga, *gb; const float* rs;
    __device__ __forceinline__ void operator()(const f32x4 (&acc)[2][2][4][2], const Unit& u, int wr, int wc, int fr, int fq) const {
        const int pn = u.pn; bf16_t* base; int ld, colt; bool sig = false;
        if (pn < 3) { base = qkv; ld = 768; colt = pn * 256; } else if (pn < 10) { base = rwb; ld = 1792; colt = (pn - 3) * 256; }
        else if (pn < 14) { base = ga; ld = 1024; colt = (pn - 10) * 256; sig = true; } else { base = gb; ld = 1024; colt = (pn - 14) * 256; sig = true; }
        const int row0 = u.pm * BM + wr * 64 + fr, col0 = colt + wc * 32 + 8 * fq;
#pragma unroll
        for (int ai = 0; ai < 2; ++ai)
#pragma unroll
            for (int m = 0; m < 4; ++m) { const int row = row0 + ai * HALF + m * 16; const float s = rs[row]; bf16_t* rowp = base + (size_t)row * ld + col0;
#pragma unroll
                for (int bj = 0; bj < 2; ++bj) { f32x4 v0 = acc[ai][bj][m][0] * s, v1 = acc[ai][bj][m][1] * s;
                    if (sig) {
#pragma unroll
                        for (int e = 0; e < 4; ++e) { v0[e] = sigmoidf_fast(v0[e]); v1[e] = sigmoidf_fast(v1[e]); } }
                    *(u32x4*)(rowp + bj * HALF) = pack8(v0, v1); } }
    }
};
struct EpiMix1 {
    static constexpr bool PERM = true, AFTER_DRAIN = false;
    const bf16_t* ga; bf16_t* p1;
    __device__ __forceinline__ void operator()(const f32x4 (&acc)[2][2][4][2], const Unit& u, int wr, int wc, int fr, int fq) const {
        const int row0 = u.pm * BM + wr * 64 + fr, col0 = u.pn * BM + wc * 32 + 8 * fq;
#pragma unroll
        for (int ai = 0; ai < 2; ++ai)
#pragma unroll
            for (int m = 0; m < 4; ++m) { const size_t off = (size_t)(row0 + ai * HALF + m * 16) * 1024 + col0;
#pragma unroll
                for (int bj = 0; bj < 2; ++bj) { const u32x4 g = *(const u32x4*)(ga + off + bj * HALF);
                    f32x4 v0 = acc[ai][bj][m][0], v1 = acc[ai][bj][m][1];
                    v0[0] *= bflo(g.x); v0[1] *= bfhi(g.x); v0[2] *= bflo(g.y); v0[3] *= bfhi(g.y); v1[0] *= bflo(g.z); v1[1] *= bfhi(g.z); v1[2] *= bflo(g.w); v1[3] *= bfhi(g.w);
                    *(u32x4*)(p1 + off + bj * HALF) = pack8(v0, v1); } }
    }
};
struct EpiMix2 {
    static constexpr bool PERM = true, AFTER_DRAIN = false;
    const bf16_t* gb; const bf16_t* p1; bf16_t* mix;
    __device__ __forceinline__ void operator()(const f32x4 (&acc)[2][2][4][2], const Unit& u, int wr, int wc, int fr, int fq) const {
        const int row0 = u.pm * BM + wr * 64 + fr, col0 = u.pn * BM + wc * 32 + 8 * fq;
#pragma unroll
        for (int ai = 0; ai < 2; ++ai)
#pragma unroll
            for (int m = 0; m < 4; ++m) { const size_t off = (size_t)(row0 + ai * HALF + m * 16) * 1024 + col0;
#pragma unroll
                for (int bj = 0; bj < 2; ++bj) { const u32x4 g = *(const u32x4*)(gb + off + bj * HALF); const u32x4 p = *(const u32x4*)(p1 + off + bj * HALF);
                    f32x4 v0 = acc[ai][bj][m][0], v1 = acc[ai][bj][m][1];
                    v0[0] = v0[0] * bflo(g.x) + bflo(p.x); v0[1] = v0[1] * bfhi(g.x) + bfhi(p.x); v0[2] = v0[2] * bflo(g.y) + bflo(p.y); v0[3] = v0[3] * bfhi(g.y) + bfhi(p.y);
                    v1[0] = v1[0] * bflo(g.z) + bflo(p.z); v1[1] = v1[1] * bfhi(g.z) + bfhi(p.z); v1[2] = v1[2] * bflo(g.w) + bflo(p.w); v1[3] = v1[3] * bfhi(g.w) + bfhi(p.w);
                    *(u32x4*)(mix + off + bj * HALF) = pack8(v0, v1); } }
    }
};
struct EpiWo {
    static constexpr bool PERM = true, AFTER_DRAIN = false;
    const float* xp; const float* xs; bf16_t* x1; float* ss;
    __device__ __forceinline__ void operator()(const f32x4 (&acc)[2][2][4][2], const Unit& u, int wr, int wc, int fr, int fq) const {
        const int row0 = u.pm * BM + wr * 64 + fr, col0 = u.pn * BM + wc * 32 + 8 * fq;
#pragma unroll
        for (int ai = 0; ai < 2; ++ai)
#pragma unroll
            for (int m = 0; m < 4; ++m) { const int row = row0 + ai * HALF + m * 16; const size_t off = (size_t)row * 1024 + col0;
                const float* xr = (row < 32768 ? xp + off : xs + (off - (size_t)32768 * 1024)); float q = 0.f;
#pragma unroll
                for (int bj = 0; bj < 2; ++bj) { const f32x4 a = *(const f32x4*)(xr + bj * HALF), b = *(const f32x4*)(xr + bj * HALF + 4);
                    const f32x4 v0 = acc[ai][bj][m][0] + a, v1 = acc[ai][bj][m][1] + b;
                    q += (v0[0] * v0[0] + v0[1] * v0[1]) + (v0[2] * v0[2] + v0[3] * v0[3]) + (v1[0] * v1[0] + v1[1] * v1[1]) + (v1[2] * v1[2] + v1[3] * v1[3]);
                    *(u32x4*)(x1 + off + bj * HALF) = pack8(v0, v1); }
                q += __shfl_xor(q, 16); q += __shfl_xor(q, 32);
                if (fq == 0) ss[(size_t)row * 16 + u.pn * 4 + wc] = q; }
    }
};
struct EpiUp {
    static constexpr bool PERM = true, AFTER_DRAIN = false;
    bf16_t *ug, *uv; const float* ss;
    __device__ __forceinline__ void operator()(const f32x4 (&acc)[2][2][4][2], const Unit& u, int wr, int wc, int fr, int fq) const {
        bf16_t* base = u.pn < 11 ? ug : uv; const int colt = (u.pn < 11 ? u.pn : u.pn - 11) * 256;
        const int row0 = u.pm * BM + wr * 64 + fr, col0 = colt + wc * 32 + 8 * fq;
#pragma unroll
        for (int ai = 0; ai < 2; ++ai)
#pragma unroll
            for (int m = 0; m < 4; ++m) { const int row = row0 + ai * HALF + m * 16; const f32x4* sp = (const f32x4*)(ss + (size_t)row * 16);
                const f32x4 s0 = sp[0], s1 = sp[1], s2 = sp[2], s3 = sp[3]; const f32x4 st = (s0 + s1) + (s2 + s3);
                const float s = __builtin_amdgcn_rsqf(((st[0] + st[1]) + (st[2] + st[3])) * (1.0f / 1024.0f) + 1e-6f);
                bf16_t* rowp = base + (size_t)row * 2816 + col0;
#pragma unroll
                for (int bj = 0; bj < 2; ++bj) { const f32x4 v0 = acc[ai][bj][m][0] * s, v1 = acc[ai][bj][m][1] * s; *(u32x4*)(rowp + bj * HALF) = pack8(v0, v1); } }
    }
};
struct EpiDown {
    static constexpr bool PERM = false, AFTER_DRAIN = false;
    const bf16_t* x1; float* out; float* ss;
    __device__ __forceinline__ void operator()(const f32x4 (&acc)[2][2][4][2], const Unit& u, int wr, int wc, int fr, int fq) const {
        const int row0 = u.pm * BM + wr * 64 + fr, col0 = u.pn * BM + wc * 32 + 4 * fq;
        typedef unsigned u32x2 __attribute__((ext_vector_type(2)));
#pragma unroll
        for (int ai = 0; ai < 2; ++ai)
#pragma unroll
            for (int m = 0; m < 4; ++m) { const int row = row0 + ai * HALF + m * 16; const size_t off = (size_t)row * 1024 + col0; float q = 0.f;
#pragma unroll
                for (int bj = 0; bj < 2; ++bj)
#pragma unroll
                    for (int n = 0; n < 2; ++n) { const u32x2 b = *(const u32x2*)(x1 + off + bj * HALF + n * 16);
                        f32x4 v = acc[ai][bj][m][n]; v[0] += bflo(b.x); v[1] += bfhi(b.x); v[2] += bflo(b.y); v[3] += bfhi(b.y);
                        q += (v[0] * v[0] + v[1] * v[1]) + (v[2] * v[2] + v[3] * v[3]);
                        *(f32x4*)(out + off + bj * HALF + n * 16) = v; }
                q += __shfl_xor(q, 16); q += __shfl_xor(q, 32);
                if (fq == 0) ss[(size_t)row * 16 + u.pn * 4 + wc] = q; }
    }
};

template <class Epi, class Sched, bool ALIGN_EPI = false, bool SP2 = false>
__device__ __forceinline__ void gemm_phase(PG8_LAS unsigned char* lds, const Gemm g, const Sched& S, const Epi& E) {
    const int tid = threadIdx.x, wid = __builtin_amdgcn_readfirstlane(tid >> 6), lane = tid & 63, wr = wid >> 2, wc = wid & 3, fr = lane & 15, fq = lane >> 4;
    const int K = g.K, nt = K / BK;
    unsigned voffA[2], voffB[2];
#pragma unroll
    for (int i = 0; i < 2; ++i) { int R, C; stage_rc(tid * 16 + i * 8192, R, C); const int Rb = Epi::PERM ? ((R & ~31) + perm32(R & 31)) : R;
        voffA[i] = (unsigned)(R * g.lda + C) * 2u; voffB[i] = (unsigned)(Rb * g.ldb + C) * 2u; }
    const size_t kstep = (size_t)(BK * 2);
    const size_t hstepA = (size_t)HALF * g.lda * 2, hstepB = (size_t)g.bhalf_rows * g.ldb * 2;
    const size_t tstepA = (size_t)BM * g.lda * 2, tstepB = (size_t)g.btile_rows * g.ldb * 2;
    const unsigned ldsw = (unsigned)wid * 1024u;
    const int aoff = lds_byte(wr * 64 + fr, fq * 8), boff = lds_byte(wc * 32 + fr, fq * 8);
#define PG8_SA(b, h) (((b) * 2 + (h)) * HTB)
#define PG8_SB(b, h) ((4 + (b) * 2 + (h)) * HTB)
#define PG8_STAGE(bufoff, gbase, voff) do { _Pragma("unroll") for (int _i = 0; _i < 2; ++_i) \
        __builtin_amdgcn_global_load_lds((const unsigned*)((const char*)(gbase) + (voff)[_i]), (PG8_LAS unsigned*)(lds + (bufoff) + ldsw + _i * 8192), 16, 0, 0); } while (0)
#define PG8_LDA(dst, b, h) do { _Pragma("unroll") for (int m = 0; m < 4; ++m) _Pragma("unroll") for (int k = 0; k < 2; ++k) dst[m][k] = *(const PG8_LAS bf16x8*)(lds + PG8_SA(b, h) + aoff + m * 2048 + k * 1024); } while (0)
#define PG8_LDB(dst, b, h) do { _Pragma("unroll") for (int n = 0; n < 2; ++n) _Pragma("unroll") for (int k = 0; k < 2; ++k) dst[n][k] = *(const PG8_LAS bf16x8*)(lds + PG8_SB(b, h) + boff + n * 2048 + k * 1024); } while (0)
#define PG8_MMA(ai, bj, At, Bt) do { __builtin_amdgcn_s_setprio(1); _Pragma("unroll") for (int m = 0; m < 4; ++m) _Pragma("unroll") for (int n = 0; n < 2; ++n) _Pragma("unroll") for (int k = 0; k < 2; ++k) \
        acc[ai][bj][m][n] = __builtin_amdgcn_mfma_f32_16x16x32_bf16(Bt[n][k], At[m][k], acc[ai][bj][m][n], 0, 0, 0); __builtin_amdgcn_s_setprio(0); } while (0)
#define PG8_WAIT_V(n) asm volatile("s_waitcnt vmcnt(" #n ")" ::: "memory")
#define PG8_WAIT_L(n) asm volatile("s_waitcnt lgkmcnt(" #n ")" ::: "memory")
#define PG8_BAR __builtin_amdgcn_s_barrier()
#define PG8_SCHED __builtin_amdgcn_sched_barrier(0)
    Unit cur, nxt; int ui = 0;
    if (!S.next(0, cur)) return;
    f32x4 acc[2][2][4][2];
#pragma unroll
    for (int a = 0; a < 2; ++a)
#pragma unroll
        for (int b = 0; b < 2; ++b)
#pragma unroll
            for (int m = 0; m < 4; ++m)
#pragma unroll
                for (int n = 0; n < 2; ++n) acc[a][b][m][n] = (f32x4){0.f, 0.f, 0.f, 0.f};
    bf16x8 At[4][2], B0[2][2], B1[2][2];
    const char* cA = (const char*)g.A + (size_t)cur.pm * tstepA; const char* cB = (const char*)g.Bt + (size_t)cur.pn * tstepB;
    S.a_ready(cur);
    if constexpr (SP2) {
        PG8_STAGE(PG8_SB(0, 0), cB, voffB); PG8_STAGE(PG8_SB(0, 1), cB + hstepB, voffB); PG8_STAGE(PG8_SA(0, 0), cA, voffA); PG8_STAGE(PG8_SA(0, 1), cA + hstepA, voffA);
        if (wr == 1) PG8_BAR;
        PG8_WAIT_V(2); PG8_BAR;
        PG8_STAGE(PG8_SB(1, 0), cB + kstep, voffB); PG8_STAGE(PG8_SA(1, 0), cA + kstep, voffA); PG8_STAGE(PG8_SB(1, 1), cB + hstepB + kstep, voffB);
        PG8_WAIT_V(6); PG8_BAR;
    } else {
        PG8_STAGE(PG8_SB(0, 0), cB, voffB); PG8_STAGE(PG8_SA(0, 0), cA, voffA); PG8_STAGE(PG8_SB(0, 1), cB + hstepB, voffB); PG8_STAGE(PG8_SA(0, 1), cA + hstepA, voffA);
        if (wr == 1) PG8_BAR;
        PG8_WAIT_V(4); PG8_BAR;
        PG8_STAGE(PG8_SB(1, 0), cB + kstep, voffB); PG8_STAGE(PG8_SA(1, 0), cA + kstep, voffA); PG8_STAGE(PG8_SB(1, 1), cB + hstepB + kstep, voffB);
        PG8_WAIT_V(6); PG8_BAR;
    }
    for (;;) {
        const bool has_next = S.next(ui + 1, nxt);
        const char* nA = has_next ? (const char*)g.A + (size_t)nxt.pm * tstepA : cA; const char* nB = has_next ? (const char*)g.Bt + (size_t)nxt.pn * tstepB : cB;
        for (int t = 0; t < nt; t += 2) {
            const bool last = (t == nt - 2);
            const char* a1 = cA + (size_t)(t + 1) * kstep;
            const char* a2 = last ? nA : cA + (size_t)(t + 2) * kstep; const char* b2 = last ? nB : cB + (size_t)(t + 2) * kstep;
            const char* a3 = a2 + kstep; const char* b3 = b2 + kstep;
            if (last && has_next) S.a_ready(nxt);
            if constexpr (SP2) {
            PG8_LDB(B0, 0, 0); PG8_LDB(B1, 0, 1); PG8_SCHED; PG8_LDA(At, 0, 0); PG8_STAGE(PG8_SA(1, 1), a1 + hstepA, voffA);
            PG8_WAIT_V(8); PG8_WAIT_L(0); PG8_BAR; PG8_MMA(0, 0, At, B0); PG8_MMA(0, 1, At, B1); PG8_BAR; PG8_SCHED;
            PG8_LDA(At, 0, 1); PG8_STAGE(PG8_SB(0, 0), b2, voffB); PG8_STAGE(PG8_SB(0, 1), b2 + hstepB, voffB); PG8_STAGE(PG8_SA(0, 0), a2, voffA);
            PG8_WAIT_V(8); PG8_WAIT_L(0); PG8_BAR; PG8_MMA(1, 0, At, B0); PG8_MMA(1, 1, At, B1); PG8_BAR; PG8_SCHED;
            PG8_LDB(B0, 1, 0); PG8_LDB(B1, 1, 1); PG8_SCHED; PG8_LDA(At, 1, 0); PG8_STAGE(PG8_SA(0, 1), a2 + hstepA, voffA);
            PG8_WAIT_V(8); PG8_WAIT_L(0); PG8_BAR; PG8_MMA(0, 0, At, B0); PG8_MMA(0, 1, At, B1); PG8_BAR; PG8_SCHED;
            PG8_LDA(At, 1, 1); PG8_STAGE(PG8_SB(1, 0), b3, voffB); PG8_STAGE(PG8_SB(1, 1), b3 + hstepB, voffB); PG8_STAGE(PG8_SA(1, 0), a3, voffA);
            PG8_WAIT_V(8); PG8_WAIT_L(0); PG8_BAR; PG8_MMA(1, 0, At, B0); PG8_MMA(1, 1, At, B1); PG8_BAR; PG8_SCHED;
            } else {
            PG8_LDB(B0, 0, 0); PG8_SCHED; PG8_LDA(At, 0, 0); PG8_STAGE(PG8_SA(1, 1), a1 + hstepA, voffA);
            PG8_WAIT_L(8); PG8_BAR; PG8_WAIT_L(0); PG8_MMA(0, 0, At, B0); PG8_BAR; PG8_SCHED;
            PG8_LDB(B1, 0, 1); PG8_STAGE(PG8_SB(0, 0), b2, voffB);
            PG8_BAR; PG8_WAIT_L(0); PG8_MMA(0, 1, At, B1); PG8_BAR;
            PG8_LDA(At, 0, 1); PG8_STAGE(PG8_SA(0, 0), a2, voffA);
            PG8_BAR; PG8_WAIT_L(0); PG8_MMA(1, 0, At, B0); PG8_BAR; PG8_SCHED;
            PG8_STAGE(PG8_SB(0, 1), b2 + hstepB, voffB);
            PG8_WAIT_V(6); PG8_BAR; PG8_MMA(1, 1, At, B1); PG8_BAR;
            PG8_LDB(B0, 1, 0); PG8_SCHED; PG8_LDA(At, 1, 0); PG8_STAGE(PG8_SA(0, 1), a2 + hstepA, voffA);
            PG8_WAIT_L(8); PG8_BAR; PG8_WAIT_L(0); PG8_MMA(0, 0, At, B0); PG8_BAR; PG8_SCHED;
            PG8_LDB(B1, 1, 1); PG8_STAGE(PG8_SB(1, 0), b3, voffB);
            PG8_BAR; PG8_WAIT_L(0); PG8_MMA(0, 1, At, B1); PG8_BAR;
            PG8_LDA(At, 1, 1); PG8_STAGE(PG8_SA(1, 0), a3, voffA);
            PG8_BAR; PG8_WAIT_L(0); PG8_MMA(1, 0, At, B0); PG8_BAR; PG8_SCHED;
            PG8_STAGE(PG8_SB(1, 1), b3 + hstepB, voffB);
            PG8_WAIT_V(6); PG8_BAR; PG8_MMA(1, 1, At, B1); PG8_BAR;
            }
        }
        if constexpr (ALIGN_EPI) { if (wr == 0) PG8_BAR; }
        if constexpr (!Epi::AFTER_DRAIN) { E(acc, cur, wr, wc, fr, fq); S.done(cur); }
        if (!has_next) break;
#pragma unroll
        for (int a = 0; a < 2; ++a)
#pragma unroll
            for (int b = 0; b < 2; ++b)
#pragma unroll
                for (int m = 0; m < 4; ++m)
#pragma unroll
                    for (int n = 0; n < 2; ++n) acc[a][b][m][n] = (f32x4){0.f, 0.f, 0.f, 0.f};
        cur = nxt; cA = nA; cB = nB; ++ui;
        if constexpr (ALIGN_EPI) { if (wr == 1) PG8_BAR; }
    }
    PG8_WAIT_V(0);
    if constexpr (!ALIGN_EPI) { if (wr == 0) PG8_BAR; }
    PG8_BAR;
    if constexpr (Epi::AFTER_DRAIN) { E.fused(acc, cur, wr, wc, fr, fq, lds, wid, lane); S.done(cur); }
#undef PG8_SA
#undef PG8_SB
#undef PG8_STAGE
#undef PG8_LDA
#undef PG8_LDB
#undef PG8_MMA
#undef PG8_WAIT_V
#undef PG8_WAIT_L
#undef PG8_BAR
#undef PG8_SCHED
}
}

#define GAS __attribute__((address_space(1)))
#define LAS __attribute__((address_space(3)))
typedef unsigned short bf16;
typedef unsigned v4u __attribute__((ext_vector_type(4)));
typedef float f32x4 __attribute__((ext_vector_type(4)));
typedef short bf16x8 __attribute__((ext_vector_type(8)));
typedef GAS unsigned gu32;
typedef GAS unsigned long long gu64;
#define RLX_AGENT __ATOMIC_RELAXED, __HIP_MEMORY_SCOPE_AGENT
#define LDS_WAIT() asm volatile("s_waitcnt lgkmcnt(0)" ::: "memory")
#define VM_WAIT() asm volatile("s_waitcnt vmcnt(0)" ::: "memory")
__device__ __forceinline__ unsigned long long rt() { return __builtin_amdgcn_s_memrealtime(); }
__device__ __forceinline__ unsigned f2bf(float f) { unsigned u = __builtin_bit_cast(unsigned, f); return (u + 0x7fffu + ((u >> 16) & 1u)) >> 16; }
__device__ __forceinline__ unsigned pk2(float lo, float hi) { return f2bf(lo) | (f2bf(hi) << 16); }

#define XB_TMO      128
#define XB_XCNT(j)  (256  + 64 * (j))
#define XB_XSUB(j)  (1280 + 64 * (j))
#define XB_XGEN(j)  (2304 + 64 * (j))
#define XB_TOP      3328
#define XB_TOPGEN   3392
#define XCD_BAR_WORDS 3456
#define XB_SPIN_CAP (1u << 18)

__device__ __forceinline__ unsigned xb_ld(unsigned* p)              { return __hip_atomic_load(p, __ATOMIC_RELAXED, __HIP_MEMORY_SCOPE_AGENT); }
__device__ __forceinline__ unsigned xb_add(unsigned* p, unsigned v) { return __hip_atomic_fetch_add(p, v, __ATOMIC_RELAXED, __HIP_MEMORY_SCOPE_AGENT); }
__device__ __forceinline__ unsigned xb_xcc_id() { return (unsigned)__builtin_amdgcn_s_getreg((3 << 11) | 20) & 0xFu; }
#define XB_SPIN(cond, bar) do { unsigned _sp = 0; while (cond) { __builtin_amdgcn_s_sleep(1); \
    if ((++_sp & 255u) == 0u) { if (xb_ld(&(bar)[XB_TMO])) break; if (_sp > XB_SPIN_CAP) { atomicAdd(&(bar)[XB_TMO], 1u); break; } } } } while (0)

struct XcdBarrier {
    unsigned* bar; unsigned x;
    volatile LAS unsigned* st;
};

__device__ __forceinline__ XcdBarrier xcd_barrier_post(unsigned* bar, volatile LAS unsigned* st) {
    XcdBarrier b; b.bar = bar; b.x = xb_xcc_id(); b.st = st;
    if (threadIdx.x == 0) (void)xb_add(&bar[XB_XCNT(b.x)], 1u);
    return b;
}
__device__ __forceinline__ void xcd_barrier_complete(unsigned* bar, unsigned x, unsigned& nloc, unsigned& nx) {
    const unsigned G = gridDim.x * gridDim.y * gridDim.z;
    unsigned sum, cnt, mine, sp = 0u;
    for (;;) {
        sum = 0u; cnt = 0u; mine = 0u;
#pragma unroll
        for (unsigned j = 0; j < 16; ++j) { const unsigned c = xb_ld(&bar[XB_XCNT(j)]); sum += c; cnt += (c > 0u) ? 1u : 0u; mine = (j == x) ? c : mine; }
        if (sum == G) break;
        __builtin_amdgcn_s_sleep(1);
        if ((++sp & 255u) == 0u) { if (xb_ld(&bar[XB_TMO])) break; if (sp > XB_SPIN_CAP) { atomicAdd(&bar[XB_TMO], 1u); break; } }
    }
    nloc = mine > 0u ? mine : 1u; nx = cnt > 0u ? cnt : 1u;
}

__device__ __forceinline__ void xcd_barrier(const XcdBarrier& b) {
    asm volatile("s_waitcnt vmcnt(0)" ::: "memory");
    __syncthreads();
    if (threadIdx.x == 0) {
        unsigned* bar = b.bar;
        __builtin_amdgcn_s_waitcnt(0);
        unsigned nloc = b.st[0], nx = b.st[1];
        if (nloc == 0u) { xcd_barrier_complete(bar, b.x, nloc, nx); b.st[0] = nloc; b.st[1] = nx; }
        const unsigned old = xb_add(&bar[XB_XSUB(b.x)], 1u);
        const unsigned gen = old / nloc;
        if (old + 1u == (gen + 1u) * nloc) {
            __builtin_amdgcn_fence(__ATOMIC_RELEASE, "agent");
            asm volatile("s_waitcnt vmcnt(0)" ::: "memory");
            const unsigned og = xb_add(&bar[XB_TOP], 1u);
            const unsigned tg = og / nx;
            if (og + 1u == (tg + 1u) * nx) xb_add(&bar[XB_TOPGEN], 1u);
            else XB_SPIN(xb_ld(&bar[XB_TOPGEN]) == tg, bar);
            __builtin_amdgcn_fence(__ATOMIC_ACQUIRE, "agent");
            xb_add(&bar[XB_XGEN(b.x)], 1u);
            asm volatile("s_waitcnt vmcnt(0)" ::: "memory");
        } else {
            XB_SPIN(xb_ld(&bar[XB_XGEN(b.x)]) == gen, bar);
            __builtin_amdgcn_fence(__ATOMIC_ACQUIRE, "agent");
            asm volatile("s_waitcnt vmcnt(0)" ::: "memory");
        }
    }
    __syncthreads();
}


constexpr int NWAVES = 8;
constexpr int DM = 1024, SEQ = 2048, NB = 16, DECB = 128, DECT = 8;
constexpr int MP = NB * SEQ, MS = DECB * DECT, M = MP + MS;
constexpr int QKVW = 768, RWS = 1792, INC = 4608, DFF = 2816, RW = 512;
constexpr int PAST = 16384;
#ifndef MK_N_LAUNCHES
#define MK_N_LAUNCHES 11
#endif
constexpr int NPH = 11;
constexpr int N_LAUNCHES = MK_N_LAUNCHES;

constexpr size_t MiB = 1u << 20;
constexpr size_t WS_CTL = 0, CTL_ZERO_BYTES = 1 * MiB;
constexpr size_t WS_WIN = 2 * MiB, WS_WPA = 11 * MiB, WS_WPB = 12 * MiB, WS_WO = 13 * MiB, WS_WUP = 15 * MiB, WS_WDN = 26 * MiB;
constexpr size_t WS_RS1 = 32 * MiB, WS_SS2 = 33 * MiB, WS_SS3 = 36 * MiB;
constexpr size_t WS_BUFA = 40 * MiB;
constexpr size_t WS_QKV = 106 * MiB;
constexpr size_t WS_RWB = 156 * MiB;
constexpr size_t WS_GA = 272 * MiB;
constexpr size_t WS_GB = 338 * MiB;
constexpr size_t WS_ATT = 404 * MiB;
constexpr size_t WS_RWO = 437 * MiB;
constexpr size_t WS_ASIG = 470 * MiB;
constexpr size_t WS_UG = 106 * MiB;
constexpr size_t WS_UV = 288 * MiB;
constexpr size_t WS_END = 503 * MiB;
constexpr int CW_TMO = 0, CW_CODE = 1, CW_BAR = 4096;
constexpr size_t O_Y = 0, O_PWK = 34603008, O_PWV = 34865152, O_PSH = 35127296, O_PWKV = 35155968, O_PCONV = 35680256,
                 O_SWK = 35770368, O_SWV = 37867520, O_SSH = 39964672, O_SWKV = 40194048, O_SCONV = 44388352;
constexpr int RING_OFF = 0, RING_BYTES = 131072;
constexpr int LDSCTL_OFF = RING_BYTES, MISC_OFF = LDSCTL_OFF + 320;
constexpr int LDS_BYTES = 147456;

__device__ const unsigned char T5_BUCKET[128] = {0, 1, 2, 3, 4, 5, 6, 7, 8, 9, 10, 11, 12, 13, 14, 15, 16, 16, 16, 17, 17, 18, 18, 18, 19, 19, 19, 20, 20, 20, 20, 21, 21, 21, 21, 22, 22, 22, 22, 22, 23, 23, 23, 23, 23, 23, 24, 24, 24, 24, 24, 24, 25, 25, 25, 25, 25, 25, 25, 26, 26, 26, 26, 26, 26, 26, 26, 27, 27, 27, 27, 27, 27, 27, 27, 27, 27, 28, 28, 28, 28, 28, 28, 28, 28, 28, 28, 29, 29, 29, 29, 29, 29, 29, 29, 29, 29, 29, 29, 30, 30, 30, 30, 30, 30, 30, 30, 30, 30, 30, 30, 30, 30, 31, 31, 31, 31, 31, 31, 31, 31, 31, 31, 31, 31, 31, 31, 31};

struct Frame {
    LAS unsigned char* lds;
    volatile LAS unsigned* MISC;
    gu32* ctl;
    int tid, lane, wave;
    int vcu, G;
};
__device__ __forceinline__ float bf2f(bf16 h) { return __builtin_bit_cast(float, (unsigned)h << 16); }
__device__ __forceinline__ float bflo(unsigned w) { return __builtin_bit_cast(float, w << 16); }
__device__ __forceinline__ float bfhi(unsigned w) { return __builtin_bit_cast(float, w & 0xffff0000u); }
__device__ __forceinline__ float wave_sum(float v) {
#pragma unroll
    for (int o = 1; o < 64; o <<= 1) v += __shfl_xor(v, o);
    return v;
}
__device__ __forceinline__ float sigmoidf_(float x) { return 1.0f / (1.0f + __expf(-x)); }

struct Args { const float* in[31]; float* out; unsigned char* ws; int ph_lo, ph_hi, li, pad; };

__device__ __forceinline__ void p0_transpose_item(const float* W, const float* kscale, int K, int N, bf16* WT, LAS float* scr, int item, int lane) {
    const int nblk = N / 32, kb = item / nblk, nb = item % nblk, k0 = 64 * kb, n0 = 32 * nb;
#pragma unroll 8
    for (int i = 0; i < 32; ++i) { const int kk = 2 * i + (lane >> 5); const float s = kscale ? kscale[k0 + kk] : 1.0f; scr[kk * 33 + (lane & 31)] = W[(size_t)(k0 + kk) * N + n0 + (lane & 31)] * s; }
    LDS_WAIT(); asm volatile("" ::: "memory");
    const int c = lane & 7;
#pragma unroll
    for (int j = 0; j < 4; ++j) { const int n = (lane >> 3) + 8 * j; const LAS float* s = scr + (8 * c) * 33 + n;
        v4u o; o.x = pk2(s[0 * 33], s[1 * 33]); o.y = pk2(s[2 * 33], s[3 * 33]); o.z = pk2(s[4 * 33], s[5 * 33]); o.w = pk2(s[6 * 33], s[7 * 33]);
        *(GAS v4u*)(WT + (size_t)(n0 + n) * K + k0 + 8 * c) = o; }
    LDS_WAIT(); asm volatile("" ::: "memory");
}
__device__ __forceinline__ void p0_prologue(Frame& F, const Args& a) {
    unsigned char* ws = a.ws;
    LAS float* scr = (LAS float*)(F.lds + RING_OFF + F.wave * 16384);
    const int gw = F.vcu * NWAVES + F.wave, NGW = F.G * NWAVES;
    constexpr int I_IN = (DM / 64) * (INC / 32), I_PA = (RW / 64) * (DM / 32), I_O = (DM / 64) * (DM / 32), I_UP = (DM / 64) * (2 * DFF / 32), I_DN = (DFF / 64) * (DM / 32);
    constexpr int NITEMS = I_IN + 2 * I_PA + I_O + I_UP + I_DN;
    for (int it = gw; it < NITEMS; it += NGW) {
        int r = it;
        if (r < I_IN) { p0_transpose_item(a.in[9], a.in[8], DM, INC, (bf16*)(ws + WS_WIN), scr, r, F.lane); continue; } r -= I_IN;
        if (r < I_PA) { p0_transpose_item(a.in[22], nullptr, RW, DM, (bf16*)(ws + WS_WPA), scr, r, F.lane); continue; } r -= I_PA;
        if (r < I_PA) { p0_transpose_item(a.in[23], nullptr, RW, DM, (bf16*)(ws + WS_WPB), scr, r, F.lane); continue; } r -= I_PA;
        if (r < I_O) { p0_transpose_item(a.in[24], nullptr, DM, DM, (bf16*)(ws + WS_WO), scr, r, F.lane); continue; } r -= I_O;
        if (r < I_UP) { p0_transpose_item(a.in[26], a.in[25], DM, 2 * DFF, (bf16*)(ws + WS_WUP), scr, r, F.lane); continue; } r -= I_UP;
        p0_transpose_item(a.in[29], nullptr, DFF, DM, (bf16*)(ws + WS_WDN), scr, r, F.lane);
    }
    bf16* XB = (bf16*)(ws + WS_BUFA); float* RS1 = (float*)(ws + WS_RS1);
    for (int m = gw; m < M; m += NGW) {
        const float* xrow = (m < MP) ? a.in[0] + (size_t)m * DM : a.in[1] + (size_t)(m - MP) * DM;
        const GAS f32x4* xr = (const GAS f32x4*)xrow + F.lane;
        f32x4 v[4]; float s = 0.f;
#pragma unroll
        for (int j = 0; j < 4; ++j) { v[j] = xr[64 * j]; s += (v[j].x * v[j].x + v[j].y * v[j].y) + (v[j].z * v[j].z + v[j].w * v[j].w); }
        s = wave_sum(s);
        if (F.lane == 0) RS1[m] = 1.0f / sqrtf(s * (1.0f / DM) + 1e-6f);
        GAS unsigned long long* o8 = (GAS unsigned long long*)(XB + (size_t)m * DM) + F.lane;
#pragma unroll
        for (int j = 0; j < 4; ++j) o8[64 * j] = (unsigned long long)pk2(v[j].x, v[j].y) | ((unsigned long long)pk2(v[j].z, v[j].w) << 32);
    }
}

constexpr int KPITCH = 72;
__device__ __forceinline__ void attn_v1(Frame& F, const Args& a) {
    unsigned char* ws = a.ws;
    const bf16* QKV = (const bf16*)(ws + WS_QKV); bf16* ATT = (bf16*)(ws + WS_ATT);
    LAS bf16* Ks = (LAS bf16*)(F.lds); LAS bf16* Vs = Ks + 256 * KPITCH; LAS float* biasT = (LAS float*)(F.lds + 2 * 256 * KPITCH * 2);
    const float* relb = a.in[7]; const float* sinks = a.in[10]; const float* cwk = a.in[2]; const float* cwv = a.in[3];
    const int tid = F.tid;
    for (int u = F.vcu; u < 768; u += F.G) {
        const bool prompt = u < 512;
        int b, qb, kv; if (prompt) { b = u >> 5; qb = (u >> 1) & 15; kv = u & 1; } else { b = (u - 512) >> 1; qb = 0; kv = u & 1; }
        __syncthreads();
        for (int c = tid; c < 2048; c += 512) {
            const int li = c >> 3, ch = c & 7; v4u kvv = (v4u){0u, 0u, 0u, 0u}, vvv = kvv;
            if (prompt) { const int pos = 128 * qb - 128 + li;
                if (pos >= 0) { const bf16* src = QKV + (size_t)(b * SEQ + pos) * QKVW + 512 + kv * 64 + ch * 8; kvv = *(const GAS v4u*)src; vvv = *(const GAS v4u*)(src + 128); }
            } else if (li < 128) { const float* sk = cwk + ((size_t)(b * 128 + li) * 2 + kv) * 64 + ch * 8; const float* sv = cwv + ((size_t)(b * 128 + li) * 2 + kv) * 64 + ch * 8;
                kvv.x = pk2(sk[0], sk[1]); kvv.y = pk2(sk[2], sk[3]); kvv.z = pk2(sk[4], sk[5]); kvv.w = pk2(sk[6], sk[7]);
                vvv.x = pk2(sv[0], sv[1]); vvv.y = pk2(sv[2], sv[3]); vvv.z = pk2(sv[4], sv[5]); vvv.w = pk2(sv[6], sv[7]);
            } else if (li < 128 + DECT) { const bf16* src = QKV + (size_t)(MP + b * DECT + li - 128) * QKVW + 512 + kv * 64 + ch * 8; kvv = *(const GAS v4u*)src; vvv = *(const GAS v4u*)(src + 128); }
            *(LAS v4u*)(Ks + li * KPITCH + ch * 8) = kvv; *(LAS v4u*)(Vs + li * KPITCH + ch * 8) = vvv;
        }
        { const int g = tid >> 7, d = tid & 127; biasT[g * 128 + d] = relb[(int)T5_BUCKET[d] * 8 + kv * 4 + g]; }
        __syncthreads();
        const int g = tid >> 7, qi = tid & 127, nq = prompt ? 128 : DECT;
        if (qi < nq) {
            const int row = prompt ? b * SEQ + qb * 128 + qi : MP + b * DECT + qi; const int head = kv * 4 + g;
            float q[64];
            { const GAS v4u* qp = (const GAS v4u*)(QKV + (size_t)row * QKVW + head * 64);
#pragma unroll
              for (int c = 0; c < 8; ++c) { const v4u w = qp[c]; q[8 * c + 0] = bflo(w.x) * 0.125f; q[8 * c + 1] = bfhi(w.x) * 0.125f; q[8 * c + 2] = bflo(w.y) * 0.125f; q[8 * c + 3] = bfhi(w.y) * 0.125f;
                  q[8 * c + 4] = bflo(w.z) * 0.125f; q[8 * c + 5] = bfhi(w.z) * 0.125f; q[8 * c + 6] = bflo(w.w) * 0.125f; q[8 * c + 7] = bfhi(w.w) * 0.125f; } }
            const int liq = 128 + qi; const float sink = sinks[head];
            const int dmax = prompt ? ((qb == 0) ? qi : 127) : 127;
            float mx = sink;
            for (int d = 0; d <= dmax; ++d) {
                const LAS v4u* kp = (const LAS v4u*)(Ks + (liq - d) * KPITCH); float s0 = 0.f, s1 = 0.f;
#pragma unroll
                for (int c = 0; c < 8; ++c) { const v4u w = kp[c];
                    s0 += q[8 * c + 0] * bflo(w.x); s1 += q[8 * c + 1] * bfhi(w.x); s0 += q[8 * c + 2] * bflo(w.y); s1 += q[8 * c + 3] * bfhi(w.y);
                    s0 += q[8 * c + 4] * bflo(w.z); s1 += q[8 * c + 5] * bfhi(w.z); s0 += q[8 * c + 6] * bflo(w.w); s1 += q[8 * c + 7] * bfhi(w.w); }
                const float s = (s0 + s1) + biasT[g * 128 + d]; mx = fmaxf(mx, s);
            }
            float l = __expf(sink - mx); float o[64];
#pragma unroll
            for (int c = 0; c < 64; ++c) o[c] = 0.f;
            for (int d = 0; d <= dmax; ++d) {
                const LAS v4u* kp = (const LAS v4u*)(Ks + (liq - d) * KPITCH); float s0 = 0.f, s1 = 0.f;
#pragma unroll
                for (int c = 0; c < 8; ++c) { const v4u w = kp[c];
                    s0 += q[8 * c + 0] * bflo(w.x); s1 += q[8 * c + 1] * bfhi(w.x); s0 += q[8 * c + 2] * bflo(w.y); s1 += q[8 * c + 3] * bfhi(w.y);
                    s0 += q[8 * c + 4] * bflo(w.z); s1 += q[8 * c + 5] * bfhi(w.z); s0 += q[8 * c + 6] * bflo(w.w); s1 += q[8 * c + 7] * bfhi(w.w); }
                const float p = __expf((s0 + s1) + biasT[g * 128 + d] - mx); l += p;
                const LAS v4u* vp = (const LAS v4u*)(Vs + (liq - d) * KPITCH);
#pragma unroll
                for (int c = 0; c < 8; ++c) { const v4u w = vp[c];
                    o[8 * c + 0] += p * bflo(w.x); o[8 * c + 1] += p * bfhi(w.x); o[8 * c + 2] += p * bflo(w.y); o[8 * c + 3] += p * bfhi(w.y);
                    o[8 * c + 4] += p * bflo(w.z); o[8 * c + 5] += p * bfhi(w.z); o[8 * c + 6] += p * bflo(w.w); o[8 * c + 7] += p * bfhi(w.w); }
            }
            const float rl = 1.0f / l;
            GAS v4u* op = (GAS v4u*)(ATT + (size_t)row * RW + head * 64);
#pragma unroll
            for (int c = 0; c < 8; ++c) { v4u w; w.x = pk2(o[8 * c + 0] * rl, o[8 * c + 1] * rl); w.y = pk2(o[8 * c + 2] * rl, o[8 * c + 3] * rl); w.z = pk2(o[8 * c + 4] * rl, o[8 * c + 5] * rl); w.w = pk2(o[8 * c + 6] * rl, o[8 * c + 7] * rl); op[c] = w; }
        }
    }
    float* out = a.out; const bf16* RWB = (const bf16*)(ws + WS_RWB);
    const size_t gt = (size_t)F.vcu * 512 + tid, GT = (size_t)F.G * 512;
    for (size_t i = gt; i < (size_t)NB * 128 * 128; i += GT) { const int c = (int)(i & 127), j = (int)((i >> 7) & 127), b = (int)(i >> 14);
        const bf16* src = QKV + (size_t)(b * SEQ + SEQ - 128 + j) * QKVW + 512 + c; out[O_PWK + i] = bf2f(src[0]); out[O_PWV + i] = bf2f(src[128]); }
    for (size_t i = gt; i < (size_t)DECB * 128 * 128; i += GT) { const int c = (int)(i & 127), j = (int)((i >> 7) & 127), b = (int)(i >> 14);
        if (j < 128 - DECT) { out[O_SWK + i] = cwk[(size_t)(b * 128 + j + DECT) * 128 + c]; out[O_SWV + i] = cwv[(size_t)(b * 128 + j + DECT) * 128 + c]; }
        else { const bf16* src = QKV + (size_t)(MP + b * DECT + j - (128 - DECT)) * QKVW + 512 + c; out[O_SWK + i] = bf2f(src[0]); out[O_SWV + i] = bf2f(src[128]); } }
    for (size_t i = gt; i < (size_t)NB * RWS; i += GT) { const int c = (int)(i % RWS), b = (int)(i / RWS); out[O_PSH + i] = bf2f(RWB[(size_t)(b * SEQ + SEQ - 1) * RWS + c]); }
    for (size_t i = gt; i < (size_t)DECB * RWS; i += GT) { const int c = (int)(i % RWS), b = (int)(i / RWS); out[O_SSH + i] = bf2f(RWB[(size_t)(MP + b * DECT + DECT - 1) * RWS + c]); }
}

__device__ __forceinline__ float rw_prev(const bf16* RWB, const float* sshift, int row, int col) {
    if (row < MP) { return ((row & (SEQ - 1)) == 0) ? 0.f : bf2f(RWB[(size_t)(row - 1) * RWS + col]); }
    const int ms = row - MP; return ((ms & (DECT - 1)) == 0) ? sshift[(size_t)(ms >> 3) * RWS + col] : bf2f(RWB[(size_t)(row - 1) * RWS + col]);
}
__device__ __forceinline__ void rwkv_prep_v1(Frame& F, const Args& a) {
    unsigned char* ws = a.ws;
    const bf16* RWB = (const bf16*)(ws + WS_RWB); float* DEC = (float*)(ws + WS_BUFA); bf16* ASIG = (bf16*)(ws + WS_ASIG); bf16* GO = (bf16*)(ws + WS_RWO);
    const float* sshift = a.in[4]; const float* mu = a.in[11]; const float* w0 = a.in[12]; const float* w2 = a.in[13]; const float* a0 = a.in[14]; const float* a2 = a.in[15]; const float* g2 = a.in[16];
    LAS float* lwT = (LAS float*)F.lds; LAS float* laS = lwT + 16 * 64; LAS float* sgS = laS + 16 * 64;
    const int tid = F.tid, c = tid;
    for (int u = F.vcu; u < M / 16; u += F.G) {
        __syncthreads();
#pragma unroll
        for (int k = 0; k < 8; ++k) { const int idx = tid + 512 * k, tok = idx >> 8, cc = idx & 255, col = 3 * RW + cc, row = u * 16 + tok;
            const float p = bf2f(RWB[(size_t)row * RWS + col]); const float pv = rw_prev(RWB, sshift, row, col); const float xs = p + mu[col] * (pv - p);
            if (cc < 64) lwT[tok * 64 + cc] = tanhf(xs); else if (cc < 128) laS[tok * 64 + cc - 64] = xs; else sgS[tok * 128 + cc - 128] = sigmoidf_(xs); }
        __syncthreads();
        float aw[16], aa[16], ag[16];
        { const float w0c = w0[c], a0c = a0[c];
#pragma unroll
          for (int t = 0; t < 16; ++t) { aw[t] = w0c; aa[t] = a0c; ag[t] = 0.f; } }
        for (int m4 = 0; m4 < 16; ++m4) {
            const float wa = w2[(4 * m4 + 0) * RW + c], wb = w2[(4 * m4 + 1) * RW + c], wc_ = w2[(4 * m4 + 2) * RW + c], wd = w2[(4 * m4 + 3) * RW + c];
            const float ea = a2[(4 * m4 + 0) * RW + c], eb = a2[(4 * m4 + 1) * RW + c], ec = a2[(4 * m4 + 2) * RW + c], ed = a2[(4 * m4 + 3) * RW + c];
#pragma unroll
            for (int t = 0; t < 16; ++t) { const f32x4 x = *(const LAS f32x4*)(lwT + t * 64 + 4 * m4); const f32x4 y = *(const LAS f32x4*)(laS + t * 64 + 4 * m4);
                aw[t] += x[0] * wa + x[1] * wb + x[2] * wc_ + x[3] * wd; aa[t] += y[0] * ea + y[1] * eb + y[2] * ec + y[3] * ed; }
        }
        for (int m4 = 0; m4 < 32; ++m4) {
            const float ga_ = g2[(4 * m4 + 0) * RW + c], gb_ = g2[(4 * m4 + 1) * RW + c], gc_ = g2[(4 * m4 + 2) * RW + c], gd_ = g2[(4 * m4 + 3) * RW + c];
#pragma unroll
            for (int t = 0; t < 16; ++t) { const f32x4 x = *(const LAS f32x4*)(sgS + t * 128 + 4 * m4); ag[t] += x[0] * ga_ + x[1] * gb_ + x[2] * gc_ + x[3] * gd_; }
        }
#pragma unroll
        for (int t = 0; t < 16; ++t) { const size_t o = (size_t)(u * 16 + t) * RW + c;
            const float w = aw[t]; const float nx = -w; const float sp = fmaxf(nx, 0.f) + log1pf(__expf(-fabsf(nx)));
            const float wlog = -sp - 0.5f; DEC[o] = -__expf(wlog);
            ASIG[o] = (bf16)f2bf(sigmoidf_(aa[t])); GO[o] = (bf16)f2bf(ag[t]); }
    }
}

__device__ __forceinline__ void rwkv_scan_v1(Frame& F, const Args& a) {
    unsigned char* ws = a.ws;
    const bf16* RWB = (const bf16*)(ws + WS_RWB); const float* DEC = (const float*)(ws + WS_BUFA); const bf16* ASIG = (const bf16*)(ws + WS_ASIG); bf16* GO = (bf16*)(ws + WS_RWO);
    const float* sshift = a.in[4]; const float* swkv = a.in[5]; const float* mu = a.in[11]; const float* k_k = a.in[17]; const float* k_a = a.in[18]; const float* r_k = a.in[19];
    const float* lnx_g = a.in[20]; const float* lnx_b = a.in[21];
    LAS float* Rs = (LAS float*)F.lds; LAS float* Ws = Rs + 1024; LAS float* Kq = Ws + 1024; LAS float* Vq = Kq + 1024; LAS float* As = Vq + 1024; LAS float* Bs = As + 1024;
    LAS float* Ys = Bs + 1024; LAS float* BON = Ys + 1024;
    const int tid = F.tid, wave = F.wave, lane = F.lane;
    const int NU = NB * 8 + DECB * 8;
    for (int u = F.vcu; u < NU; u += F.G) {
        const bool prompt = u < NB * 8; const int b = prompt ? (u >> 3) : ((u - NB * 8) >> 3), h = u & 7;
        const int T = prompt ? SEQ : DECT, row0 = prompt ? b * SEQ : MP + b * DECT;
        const int i = tid >> 3, jq = tid & 7;
        float S[8];
        if (prompt) {
#pragma unroll
            for (int q = 0; q < 8; ++q) S[q] = 0.f;
        } else { const float* sp = swkv + ((size_t)(b * 8 + h) * 64 + i) * 64 + 8 * jq;
#pragma unroll
            for (int q = 0; q < 8; ++q) S[q] = sp[q]; }
        for (int t0 = 0; t0 < T; t0 += 16) {
            const int nt = (T - t0) < 16 ? (T - t0) : 16;
            __syncthreads();
#pragma unroll
            for (int k = 0; k < 2; ++k) { const int tok = wave + 8 * k;
                if (tok < nt) { const int j = lane, cch = h * 64 + j, row = row0 + t0 + tok;
                    const bf16* pr = RWB + (size_t)row * RWS;
                    const float p_r = bf2f(pr[cch]), p_k = bf2f(pr[RW + cch]), p_v = bf2f(pr[2 * RW + cch]);
                    const float q_r = rw_prev(RWB, sshift, row, cch), q_k = rw_prev(RWB, sshift, row, RW + cch), q_v = rw_prev(RWB, sshift, row, 2 * RW + cch);
                    const float r = p_r + mu[cch] * (q_r - p_r), kx = p_k + mu[RW + cch] * (q_k - p_k), v = p_v + mu[2 * RW + cch] * (q_v - p_v);
                    const size_t o = (size_t)row * RW + cch;
                    const float w = __expf(DEC[o]); const float as = bf2f(ASIG[o]);
                    const float kkr = kx * k_k[cch]; const float ss = wave_sum(kkr * kkr); const float kk = kkr / fmaxf(sqrtf(ss), 1e-12f);
                    const float kp = kx * (1.0f + (as - 1.0f) * k_a[cch]);
                    const float bon = wave_sum(r * kp * r_k[cch]);
                    Rs[tok * 64 + j] = r; Ws[tok * 64 + j] = w; Kq[tok * 64 + j] = kp; Vq[tok * 64 + j] = v; As[tok * 64 + j] = -kk; Bs[tok * 64 + j] = kk * as;
                    if (j == 0) BON[tok] = bon; } }
            __syncthreads();
            for (int tok = 0; tok < nt; ++tok) {
                const f32x4 a0 = *(const LAS f32x4*)(As + tok * 64 + 8 * jq), a1 = *(const LAS f32x4*)(As + tok * 64 + 8 * jq + 4);
                const f32x4 b0 = *(const LAS f32x4*)(Bs + tok * 64 + 8 * jq), b1 = *(const LAS f32x4*)(Bs + tok * 64 + 8 * jq + 4);
                const f32x4 w0v = *(const LAS f32x4*)(Ws + tok * 64 + 8 * jq), w1v = *(const LAS f32x4*)(Ws + tok * 64 + 8 * jq + 4);
                const f32x4 k0 = *(const LAS f32x4*)(Kq + tok * 64 + 8 * jq), k1 = *(const LAS f32x4*)(Kq + tok * 64 + 8 * jq + 4);
                const f32x4 r0 = *(const LAS f32x4*)(Rs + tok * 64 + 8 * jq), r1 = *(const LAS f32x4*)(Rs + tok * 64 + 8 * jq + 4);
                const float vi = Vq[tok * 64 + i];
                float sa = 0.f;
#pragma unroll
                for (int q = 0; q < 4; ++q) { sa += S[q] * a0[q]; sa += S[4 + q] * a1[q]; }
                sa += __shfl_xor(sa, 1); sa += __shfl_xor(sa, 2); sa += __shfl_xor(sa, 4);
                float y = 0.f;
#pragma unroll
                for (int q = 0; q < 4; ++q) { S[q] = S[q] * w0v[q] + sa * b0[q] + vi * k0[q]; S[4 + q] = S[4 + q] * w1v[q] + sa * b1[q] + vi * k1[q]; y += S[q] * r0[q]; y += S[4 + q] * r1[q]; }
                y += __shfl_xor(y, 1); y += __shfl_xor(y, 2); y += __shfl_xor(y, 4);
                if (jq == 0) Ys[tok * 64 + i] = y;
            }
            __syncthreads();
#pragma unroll
            for (int k = 0; k < 2; ++k) { const int tok = wave + 8 * k;
                if (tok < nt) { const int ii = lane, cch = h * 64 + ii, row = row0 + t0 + tok;
                    const float y = Ys[tok * 64 + ii]; const float mean = wave_sum(y) * (1.0f / 64.0f); const float d = y - mean; const float var = wave_sum(d * d) * (1.0f / 64.0f);
                    float yn = d * (1.0f / sqrtf(var + 64e-5f)); yn = yn * lnx_g[cch] + lnx_b[cch] + BON[tok] * Vq[tok * 64 + ii];
                    const size_t o = (size_t)row * RW + cch; GO[o] = (bf16)f2bf(yn * bf2f(GO[o])); } }
        }
        float* so = a.out + (prompt ? O_PWKV : O_SWKV) + ((size_t)(b * 8 + h) * 64 + i) * 64 + 8 * jq;
#pragma unroll
        for (int q = 0; q < 8; ++q) so[q] = S[q];
    }
}

__device__ __forceinline__ float gelu_tanh(float x) { const float z = 0.7978845608028654f * (x + 0.044715f * x * x * x); const float e = __expf(2.0f * z); const float th = 1.0f - 2.0f / (1.0f + e); return 0.5f * x * (1.0f + th); }
__device__ __forceinline__ void act_v1(Frame& F, const Args& a) {
    unsigned char* ws = a.ws;
    const bf16* UG = (const bf16*)(ws + WS_UG); bf16* UV = (bf16*)(ws + WS_UV);
    const float* sconv = a.in[6]; const float* cw = a.in[27]; const float* cb = a.in[28]; float* out = a.out;
    const size_t gt = (size_t)F.vcu * 512 + F.tid, GT = (size_t)F.G * 512;
    constexpr int CH = DFF / 8;
    for (size_t idx = gt; idx < (size_t)M * CH; idx += GT) {
        const int row = (int)(idx / CH), n0 = (int)(idx % CH) * 8;
        float u0[8], u1[8], u2[8];
        { const v4u w = *(const GAS v4u*)(UG + (size_t)row * DFF + n0); u0[0] = bflo(w.x); u0[1] = bfhi(w.x); u0[2] = bflo(w.y); u0[3] = bfhi(w.y); u0[4] = bflo(w.z); u0[5] = bfhi(w.z); u0[6] = bflo(w.w); u0[7] = bfhi(w.w); }
        int t, b; const bool prompt = row < MP; if (prompt) { t = row & (SEQ - 1); b = row >> 11; } else { t = (row - MP) & (DECT - 1); b = (row - MP) >> 3; }
        if (t >= 1) { const v4u w = *(const GAS v4u*)(UG + (size_t)(row - 1) * DFF + n0); u1[0] = bflo(w.x); u1[1] = bfhi(w.x); u1[2] = bflo(w.y); u1[3] = bfhi(w.y); u1[4] = bflo(w.z); u1[5] = bfhi(w.z); u1[6] = bflo(w.w); u1[7] = bfhi(w.w); }
        else {
#pragma unroll
            for (int e = 0; e < 8; ++e) u1[e] = prompt ? 0.f : sconv[((size_t)b * 2 + 1) * DFF + n0 + e]; }
        if (t >= 2) { const v4u w = *(const GAS v4u*)(UG + (size_t)(row - 2) * DFF + n0); u2[0] = bflo(w.x); u2[1] = bfhi(w.x); u2[2] = bflo(w.y); u2[3] = bfhi(w.y); u2[4] = bflo(w.z); u2[5] = bfhi(w.z); u2[6] = bflo(w.w); u2[7] = bfhi(w.w); }
        else {
#pragma unroll
            for (int e = 0; e < 8; ++e) u2[e] = prompt ? 0.f : sconv[((size_t)b * 2 + t) * DFF + n0 + e]; }
        const v4u wv = *(const GAS v4u*)(UV + (size_t)row * DFF + n0);
        float uvv[8] = {bflo(wv.x), bfhi(wv.x), bflo(wv.y), bfhi(wv.y), bflo(wv.z), bfhi(wv.z), bflo(wv.w), bfhi(wv.w)};
        float r[8];
#pragma unroll
        for (int e = 0; e < 8; ++e) { const int n = n0 + e; const float c = cb[n] + cw[n] * u2[e] + cw[DFF + n] * u1[e] + cw[2 * DFF + n] * u0[e]; r[e] = gelu_tanh(c) * uvv[e]; }
        v4u o; o.x = pk2(r[0], r[1]); o.y = pk2(r[2], r[3]); o.z = pk2(r[4], r[5]); o.w = pk2(r[6], r[7]);
        *(GAS v4u*)(UV + (size_t)row * DFF + n0) = o;
        const int TT = prompt ? SEQ : DECT;
        if (t >= TT - 2) { float* dst = out + (prompt ? O_PCONV : O_SCONV) + ((size_t)b * 2 + (t - (TT - 2))) * DFF + n0;
#pragma unroll
            for (int e = 0; e < 8; ++e) dst[e] = u0[e]; }
    }
}

__device__ __forceinline__ void final_norm(Frame& F, const Args& a) {
    const float* SS3 = (const float*)(a.ws + WS_SS3); const float* fg = a.in[30];
    const int gw = F.vcu * NWAVES + F.wave, NGW = F.G * NWAVES;
    const GAS f32x4* gp = (const GAS f32x4*)fg + F.lane;
    f32x4 gv[4];
#pragma unroll
    for (int j = 0; j < 4; ++j) gv[j] = gp[64 * j];
    for (int m = gw; m < M; m += NGW) {
        float s = (F.lane < 16) ? SS3[(size_t)m * 16 + F.lane] : 0.f; s = wave_sum(s);
        const float rs = 1.0f / sqrtf(s * (1.0f / DM) + 1e-6f);
        GAS f32x4* yr = (GAS f32x4*)(a.out + (size_t)m * DM) + F.lane;
#pragma unroll
        for (int j = 0; j < 4; ++j) { f32x4 v = yr[64 * j]; v = v * rs * gv[j]; yr[64 * j] = v; }
    }
}

__global__ void __launch_bounds__(NWAVES * 64, 2) fwd(Args args) {
    extern __shared__ __attribute__((aligned(16))) unsigned char lds[];
    Frame F;
    F.lds = (LAS unsigned char*)lds;
    F.MISC = (volatile LAS unsigned*)(F.lds + MISC_OFF);
    F.tid = threadIdx.x; F.lane = F.tid & 63; F.wave = __builtin_amdgcn_readfirstlane(F.tid >> 6);
    F.G = gridDim.x; { const int bx = blockIdx.x; F.vcu = (F.G % 8 == 0) ? (bx % 8) * (F.G / 8) + bx / 8 : bx; }
    unsigned char* ws = args.ws;
    F.ctl = (gu32*)(ws + WS_CTL);
    for (int u = F.tid; u < (LDS_BYTES - LDSCTL_OFF) / 4; u += NWAVES * 64) ((LAS unsigned*)(F.lds + LDSCTL_OFF))[u] = 0u;
    __syncthreads();
    XcdBarrier bar; bar.bar = (unsigned*)(F.ctl + CW_BAR); bar.x = 0; bar.st = nullptr;
    if (N_LAUNCHES == 1) bar = xcd_barrier_post((unsigned*)(F.ctl + CW_BAR), F.MISC + 8);
#define GRID_BAR() do { if (N_LAUNCHES == 1) xcd_barrier(bar); } while (0)
    const int lo = args.ph_lo, hi = args.ph_hi;
#define IN(k) (lo <= (k) && (k) < hi)
#define BOTH(k) (IN(k) && IN((k) + 1))
    typedef pg8::bf16_t pb;
    if (IN(0)) { p0_prologue(F, args); if (BOTH(0)) GRID_BAR(); }
    if (IN(1)) {
        pg8::Gemm g{(const pb*)(ws + WS_BUFA), (const pb*)(ws + WS_WIN), M, INC, DM, DM, DM, 128, 256}; pg8::StaticOrder S; S.init(M, INC, F.G, (int)blockIdx.x);
        pg8::EpiProj E{(pb*)(ws + WS_QKV), (pb*)(ws + WS_RWB), (pb*)(ws + WS_GA), (pb*)(ws + WS_GB), (const float*)(ws + WS_RS1)};
        pg8::gemm_phase<pg8::EpiProj, pg8::StaticOrder, true, true>(F.lds + RING_OFF, g, S, E);
        if (BOTH(1)) GRID_BAR();
    }
    if (IN(2)) { attn_v1(F, args); }
    if (IN(3)) { rwkv_prep_v1(F, args); if (BOTH(3)) GRID_BAR(); }
    if (IN(4)) { rwkv_scan_v1(F, args); if (BOTH(4)) GRID_BAR(); }
    if (IN(5)) {
        { pg8::Gemm g{(const pb*)(ws + WS_ATT), (const pb*)(ws + WS_WPA), M, DM, RW, RW, RW, 128, 256}; pg8::StaticOrder S; S.init(M, DM, F.G, (int)blockIdx.x);
          pg8::EpiMix1 E{(const pb*)(ws + WS_GA), (pb*)(ws + WS_BUFA)};
          pg8::gemm_phase<pg8::EpiMix1, pg8::StaticOrder, true, true>(F.lds + RING_OFF, g, S, E); }
        asm volatile("s_waitcnt vmcnt(0)" ::: "memory"); __syncthreads();
        { pg8::Gemm g{(const pb*)(ws + WS_RWO), (const pb*)(ws + WS_WPB), M, DM, RW, RW, RW, 128, 256}; pg8::StaticOrder S; S.init(M, DM, F.G, (int)blockIdx.x);
          pg8::EpiMix2 E{(const pb*)(ws + WS_GB), (const pb*)(ws + WS_BUFA), (pb*)(ws + WS_GA)};
          pg8::gemm_phase<pg8::EpiMix2, pg8::StaticOrder, true, true>(F.lds + RING_OFF, g, S, E); }
        if (BOTH(5)) GRID_BAR();
    }
    if (IN(6)) {
        pg8::Gemm g{(const pb*)(ws + WS_GA), (const pb*)(ws + WS_WO), M, DM, DM, DM, DM, 128, 256}; pg8::StaticOrder S; S.init(M, DM, F.G, (int)blockIdx.x);
        pg8::EpiWo E{args.in[0], args.in[1], (pb*)(ws + WS_BUFA), (float*)(ws + WS_SS2)};
        pg8::gemm_phase<pg8::EpiWo, pg8::StaticOrder, true, true>(F.lds + RING_OFF, g, S, E);
        if (BOTH(6)) GRID_BAR();
    }
    if (IN(7)) {
        pg8::Gemm g{(const pb*)(ws + WS_BUFA), (const pb*)(ws + WS_WUP), M, 2 * DFF, DM, DM, DM, 128, 256}; pg8::StaticOrder S; S.init(M, 2 * DFF, F.G, (int)blockIdx.x);
        pg8::EpiUp E{(pb*)(ws + WS_UG), (pb*)(ws + WS_UV), (const float*)(ws + WS_SS2)};
        pg8::gemm_phase<pg8::EpiUp, pg8::StaticOrder, true, true>(F.lds + RING_OFF, g, S, E);
        if (BOTH(7)) GRID_BAR();
    }
    if (IN(8)) { act_v1(F, args); if (BOTH(8)) GRID_BAR(); }
    if (IN(9)) {
        pg8::Gemm g{(const pb*)(ws + WS_UV), (const pb*)(ws + WS_WDN), M, DM, DFF, DFF, DFF, 128, 256}; pg8::StaticOrder S; S.init(M, DM, F.G, (int)blockIdx.x);
        pg8::EpiDown E{(const pb*)(ws + WS_BUFA), args.out, (float*)(ws + WS_SS3)};
        pg8::gemm_phase<pg8::EpiDown, pg8::StaticOrder, true, true>(F.lds + RING_OFF, g, S, E);
        if (BOTH(9)) GRID_BAR();
    }
    if (IN(10)) { final_norm(F, args); }
#undef IN
#undef BOTH
}

extern "C" void kernel_launch(void* const* d_in, const int* in_sizes, int n_in, void* d_out, int out_size, void* d_ws, size_t ws_size, hipStream_t stream) {
    static int grid = 0;
    if (grid == 0) {
        if (n_in != 31 || out_size != 45109248 || ws_size < WS_END) { fprintf(stderr, "kernel_launch: unexpected shapes n_in %d out %d ws %zu\n", n_in, out_size, ws_size); grid = -1; return; }
        int dev = 0, cus = 0, per_cu = 0;
        if (hipGetDevice(&dev) != hipSuccess || hipDeviceGetAttribute(&cus, hipDeviceAttributeMultiprocessorCount, dev) != hipSuccess) { grid = -1; return; }
        if (hipFuncSetAttribute((const void*)fwd, hipFuncAttributeMaxDynamicSharedMemorySize, LDS_BYTES) != hipSuccess) { fprintf(stderr, "kernel_launch: hipFuncSetAttribute failed\n"); grid = -1; return; }
        if (hipOccupancyMaxActiveBlocksPerMultiprocessor(&per_cu, (const void*)fwd, NWAVES * 64, LDS_BYTES) != hipSuccess || per_cu < 1) fprintf(stderr, "kernel_launch: occupancy query says %d\n", per_cu);
        (void)hipGetLastError();
        grid = cus;
    }
    if (grid < 0) return;
    (void)hipMemsetAsync((char*)d_ws + WS_CTL, 0, CTL_ZERO_BYTES, stream);
    Args a{};
    for (int i = 0; i < 31; ++i) a.in[i] = (const float*)d_in[i];
    a.out = (float*)d_out; a.ws = (unsigned char*)d_ws;
    if (N_LAUNCHES == 1) { a.ph_lo = 0; a.ph_hi = NPH; a.li = 0; hipLaunchKernelGGL(fwd, dim3(grid), dim3(NWAVES * 64), LDS_BYTES, stream, a); }
    else { for (int li = 0; li < NPH; ++li) { a.ph_lo = li; a.ph_hi = li + 1; a.li = li; hipLaunchKernelGGL(fwd, dim3(grid), dim3(NWAVES * 64), LDS_BYTES, stream, a); } }
}
```

```cpp
#include <hip/hip_runtime.h>
#include <cstdio>
#include <cstdint>
#include <cmath>
namespace pg8 {
#define PG8_LAS __attribute__((address_space(3)))
typedef unsigned short bf16_t;
typedef short bf16x8 __attribute__((ext_vector_type(8)));
typedef float f32x4 __attribute__((ext_vector_type(4)));
typedef unsigned u32x4 __attribute__((ext_vector_type(4)));
constexpr int BM = 256, BK = 64, HALF = 128, HTB = HALF * BK * 2  , STAGE_BYTES = 8 * HTB, NXCD = 8, WGM = 8;

__host__ __device__ __forceinline__ int lds_byte(int r, int c) { const int st = (r >> 4) * 2 + (c >> 5), rr = r & 15, cc = c & 31, ob = rr * 64 + cc * 2; return st * 1024 + (ob ^ (((ob >> 9) & 1) << 5)); }
__host__ __device__ __forceinline__ void stage_rc(int b, int& R, int& C) { const int st = b / 1024, sb = b % 1024, swz = sb ^ (((sb >> 9) & 1) << 5); R = (st >> 1) * 16 + swz / 64; C = (st & 1) * 32 + (swz % 64) / 2; }
__host__ __device__ __forceinline__ int perm32(int rho) { const int n = rho >> 4, i = rho & 15; return 8 * (i >> 2) + 4 * n + (i & 3); }

struct Unit { int pm, pn, kz; };
struct Gemm { const bf16_t* A; const bf16_t* Bt; int M, N, K; int lda, ldb; int bhalf_rows, btile_rows; int ksplit; };

struct StaticOrder {
    int nM, nN, nwg, G, c;
    __host__ __device__ void init(int M, int N, int G_, int c_) { nM = M / BM; nN = N / BM; nwg = nM * nN; G = G_; c = c_; }
    __host__ __device__ __forceinline__ bool next(int i, Unit& u) const {
        const long L = (long)i * G + c; if (L >= nwg) return false;
        int wgid = (int)L; { const int q = nwg / NXCD, r = nwg % NXCD, xcd = wgid % NXCD, off = wgid / NXCD; wgid = (xcd < r ? xcd * (q + 1) : r * (q + 1) + (xcd - r) * q) + off; }
        const int nig = WGM * nN, gid = wgid / nig, fm = gid * WGM, gsz = (nM - fm) < WGM ? (nM - fm) : WGM;
        u.pm = fm + ((wgid % nig) % gsz); u.pn = (wgid % nig) / gsz; u.kz = -1; return true;
    }
    __device__ __forceinline__ void a_ready(const Unit&) const {}
    __device__ __forceinline__ void done(const Unit&) const {}
};
struct SplitTailOrder {
    StaticOrder so; int nN, ks, ntail, tail_pm0, G, c, rounds;
    __host__ __device__ void init(int mainM, int M, int N, int ksn, int G_, int c_) { so.init(mainM, N, G_, c_); nN = N / BM; ks = ksn; tail_pm0 = mainM / BM; ntail = (M - mainM) / BM * nN * ksn; G = G_; c = c_; rounds = (so.nwg + G_ - 1) / G_; }
    __host__ __device__ bool next(int i, Unit& u) const {
        const int nmain = (c < so.nwg) ? (so.nwg - c + G - 1) / G : 0;
        if (i < nmain) return so.next(i, u);
        const long j = (long)(i - nmain) * G + c; if (j >= ntail) return false;
        u.kz = (int)(j % ks); u.pn = (int)((j / ks) % nN); u.pm = tail_pm0 + (int)(j / ((long)ks * nN)); return true;
    }
    __device__ __forceinline__ void a_ready(const Unit&) const {}
    __device__ __forceinline__ void done(const Unit&) const {}
};

struct RangeOrder {
    int pm0, nN, n, G, c;
    __host__ __device__ void init(int pm0_, int npm, int N, int G_, int c_) { pm0 = pm0_; nN = N / BM; n = npm * nN; G = G_; c = c_; }
    __host__ __device__ bool next(int i, Unit& u) const { const long j = (long)i * G + c; if (c < 0 || j >= n) return false; u.pm = pm0 + (int)(j / nN); u.pn = (int)(j % nN); u.kz = -1; return true; }
    __device__ __forceinline__ void a_ready(const Unit&) const {}
    __device__ __forceinline__ void done(const Unit&) const {}
};
struct WaitOrder : StaticOrder {
    unsigned* cnt; unsigned need; int first_pm; volatile PG8_LAS unsigned* flag; unsigned* tmo;
    __device__ __forceinline__ bool next(int i, Unit& u) const { const bool ok = StaticOrder::next(i, u); u.kz = -1 - i; return ok; }
    __device__ __forceinline__ void a_ready(const Unit& u) const {
        if (u.pm < first_pm) return;
        if (threadIdx.x < 64) {
            if (*flag == 0u) { unsigned sp = 0;
                while ((unsigned)__builtin_amdgcn_readfirstlane(__hip_atomic_load(cnt, __ATOMIC_RELAXED, __HIP_MEMORY_SCOPE_AGENT)) < need) { __builtin_amdgcn_s_sleep(2); if (++sp > (1u << 22)) { if (threadIdx.x == 0) __hip_atomic_store(tmo, 1u, __ATOMIC_RELAXED, __HIP_MEMORY_SCOPE_AGENT); break; } }
                __builtin_amdgcn_fence(__ATOMIC_ACQUIRE, "agent"); asm volatile("s_waitcnt vmcnt(0)" ::: "memory");
                if (threadIdx.x == 0) *flag = 1u; asm volatile("s_waitcnt lgkmcnt(0)" ::: "memory"); }
        }
        asm volatile("" ::: "memory"); __builtin_amdgcn_s_barrier(); asm volatile("" ::: "memory");
    }
};

__device__ __forceinline__ void wg_wait(unsigned* cnt, unsigned need, unsigned* tmo) {
    if (threadIdx.x < 64) { unsigned sp = 0;
        while ((unsigned)__builtin_amdgcn_readfirstlane(__hip_atomic_load(cnt, __ATOMIC_RELAXED, __HIP_MEMORY_SCOPE_AGENT)) < need) { __builtin_amdgcn_s_sleep(2); if (++sp > (1u << 22)) { if (threadIdx.x == 0) __hip_atomic_store(tmo, 1u, __ATOMIC_RELAXED, __HIP_MEMORY_SCOPE_AGENT); break; } }
        __builtin_amdgcn_fence(__ATOMIC_ACQUIRE, "agent"); asm volatile("s_waitcnt vmcnt(0)" ::: "memory"); }
    asm volatile("" ::: "memory"); __builtin_amdgcn_s_barrier(); asm volatile("" ::: "memory");
}
__device__ __forceinline__ void wg_publish(unsigned* c0, unsigned n0, unsigned* c1, unsigned n1) {
    asm volatile("s_waitcnt vmcnt(0)" ::: "memory"); __builtin_amdgcn_s_barrier(); asm volatile("" ::: "memory");
    if (threadIdx.x == 0) { __builtin_amdgcn_fence(__ATOMIC_RELEASE, "agent"); asm volatile("s_waitcnt vmcnt(0)" ::: "memory");
        if (n0) __hip_atomic_fetch_add(c0, n0, __ATOMIC_RELAXED, __HIP_MEMORY_SCOPE_AGENT);
        if (n1) __hip_atomic_fetch_add(c1, n1, __ATOMIC_RELAXED, __HIP_MEMORY_SCOPE_AGENT); }
}
__device__ __forceinline__ void wg_publish_wt(unsigned* c0, unsigned n0, unsigned* c1, unsigned n1) {
    asm volatile("s_waitcnt vmcnt(0)" ::: "memory"); __builtin_amdgcn_s_barrier(); asm volatile("" ::: "memory");
    if (threadIdx.x == 0) {
        if (n0) __hip_atomic_fetch_add(c0, n0, __ATOMIC_RELAXED, __HIP_MEMORY_SCOPE_AGENT);
        if (n1) __hip_atomic_fetch_add(c1, n1, __ATOMIC_RELAXED, __HIP_MEMORY_SCOPE_AGENT); }
}
__device__ __forceinline__ void st_wt(__amdgpu_buffer_rsrc_t r, unsigned byte_off, u32x4 v) { __builtin_amdgcn_raw_buffer_store_b128(v, r, byte_off, 0,   16); }
__device__ __forceinline__ void st_wt(__amdgpu_buffer_rsrc_t r, unsigned byte_off, f32x4 v) { __builtin_amdgcn_raw_buffer_store_b128(__builtin_bit_cast(u32x4, v), r, byte_off, 0, 16); }
struct UpOrder {
    StaticOrder so; int mode, spm, spn; unsigned* wcnt; unsigned wneed; unsigned* tmo; int pub_round; unsigned pub_n; unsigned* pub_cnt;
    __device__ __forceinline__ bool next(int i, Unit& u) const {
        if (mode == 0) { const bool ok = so.next(i, u); u.kz = -1 - i; return ok; }
        if (i > 0) return false;
        u.pm = spm; u.pn = spn; u.kz = -1; return true;
    }
    __device__ __forceinline__ void a_ready(const Unit&) const { if (mode == 1) wg_wait(wcnt, wneed, tmo); }
    __device__ __forceinline__ void done(const Unit& u) const { if (mode == 0 && pub_round == -1 - u.kz) wg_publish_wt(pub_cnt, pub_n, pub_cnt, 0u); }
};
struct DownOrder {
    StaticOrder so; int i0, i1, j0, j1; unsigned *w0, *w1, *w2; unsigned n0, n1, n2; unsigned* tmo; unsigned* pc;
    __device__ __forceinline__ bool next(int i, Unit& u) const {
        const int k = i0 + i; if (k >= i1) return false;
        if (k < 2) return so.next(k, u);
        const int j = (k == 2) ? j0 : j1; if (j < 0) return false;
        u.kz = j % 11; u.pn = (j / 11) & 3; u.pm = so.nM + j / 44; return true;
    }
    __device__ __forceinline__ void a_ready(const Unit& u) const {
        if (u.kz >= 0) wg_wait(w2, n2, tmo); else if (u.pm & 8) wg_wait(w1, n1, tmo); else wg_wait(w0, n0, tmo);
    }
    __device__ __forceinline__ void done(const Unit& u) const {
        if (u.kz >= 0) return;
        asm volatile("s_waitcnt vmcnt(0)" ::: "memory"); __builtin_amdgcn_s_barrier(); asm volatile("" ::: "memory");
        if (threadIdx.x == 0) __hip_atomic_fetch_add(pc + u.pm * 32, 1u, __ATOMIC_RELAXED, __HIP_MEMORY_SCOPE_AGENT);
    }
};

__device__ __forceinline__ unsigned cvt_pk_bf16(float lo, float hi) { unsigned r; asm volatile("v_cvt_pk_bf16_f32 %0, %1, %2" : "=v"(r) : "v"(lo), "v"(hi)); return r; }
__device__ __forceinline__ float bflo(unsigned w) { return __builtin_bit_cast(float, w << 16); }
__device__ __forceinline__ float bfhi(unsigned w) { return __builtin_bit_cast(float, w & 0xffff0000u); }
__device__ __forceinline__ float sigmoidf_fast(float x) { return __builtin_amdgcn_rcpf(1.0f + __builtin_amdgcn_exp2f(-1.4426950408889634f * x)); }
__device__ __forceinline__ u32x4 pack8(const f32x4& v0, const f32x4& v1) { u32x4 w; w.x = cvt_pk_bf16(v0[0], v0[1]); w.y = cvt_pk_bf16(v0[2], v0[3]); w.z = cvt_pk_bf16(v1[0], v1[1]); w.w = cvt_pk_bf16(v1[2], v1[3]); return w; }

struct EpiProj {
    static constexpr bool PERM = true, AFTER_DRAIN = false;
    bf16_t *qkv, *rwb; unsigned char *ga8, *gb8; const float* rs;
    __device__ __forceinline__ void operator()(const f32x4 (&acc)[2][2][4][2], const Unit& u, int wr, int wc, int fr, int fq) const {
        typedef unsigned u32x2 __attribute__((ext_vector_type(2)));
        const int pn = u.pn; const int row0 = u.pm * BM + wr * 64 + fr;
        if (pn < 10) { bf16_t* base; int ld, colt;
            if (pn < 3) { base = qkv; ld = 768; colt = pn * 256; } else { base = rwb; ld = 1792; colt = (pn - 3) * 256; }
            const int col0 = colt + wc * 32 + 8 * fq;
#pragma unroll
            for (int ai = 0; ai < 2; ++ai)
#pragma unroll
                for (int m = 0; m < 4; ++m) { const int row = row0 + ai * HALF + m * 16; const float s = rs[row]; bf16_t* rowp = base + (size_t)row * ld + col0;
#pragma unroll
                    for (int bj = 0; bj < 2; ++bj) { const f32x4 v0 = acc[ai][bj][m][0] * s, v1 = acc[ai][bj][m][1] * s; *(u32x4*)(rowp + bj * HALF) = pack8(v0, v1); } }
        } else { unsigned char* base = (pn < 14) ? ga8 : gb8; const int col0 = ((pn < 14) ? pn - 10 : pn - 14) * 256 + wc * 32 + 8 * fq;
#pragma unroll
            for (int ai = 0; ai < 2; ++ai)
#pragma unroll
                for (int m = 0; m < 4; ++m) { const int row = row0 + ai * HALF + m * 16; const float sm = -1.4426950408889634f * rs[row]; unsigned char* rowp = base + (size_t)row * 1024 + col0;
#pragma unroll
                    for (int bj = 0; bj < 2; ++bj) { u32x2 w = {0u, 0u};
#pragma unroll
                        for (int e = 0; e < 4; ++e) {
                            const float g0 = __builtin_amdgcn_rcpf((1.0f / 255.0f) + __builtin_amdgcn_exp2f(__builtin_fmaf(acc[ai][bj][m][0][e], sm, -7.994353436858858f)));
                            const float g1 = __builtin_amdgcn_rcpf((1.0f / 255.0f) + __builtin_amdgcn_exp2f(__builtin_fmaf(acc[ai][bj][m][1][e], sm, -7.994353436858858f)));
                            w.x = __builtin_amdgcn_cvt_pk_u8_f32(g0, e, w.x); w.y = __builtin_amdgcn_cvt_pk_u8_f32(g1, e, w.y); }
                        *(u32x2*)(rowp + bj * HALF) = w; } }
        }
    }
};
__device__ __forceinline__ float ub0(unsigned w) { return (float)(w & 0xffu); }
__device__ __forceinline__ float ub1(unsigned w) { return (float)((w >> 8) & 0xffu); }
__device__ __forceinline__ float ub2(unsigned w) { return (float)((w >> 16) & 0xffu); }
__device__ __forceinline__ float ub3(unsigned w) { return (float)(w >> 24); }
struct EpiMix1 {
    static constexpr bool PERM = true, AFTER_DRAIN = false;
    const unsigned char* ga8; bf16_t* p1;
    __device__ __forceinline__ void operator()(const f32x4 (&acc)[2][2][4][2], const Unit& u, int wr, int wc, int fr, int fq) const {
        typedef unsigned u32x2 __attribute__((ext_vector_type(2)));
        const int row0 = u.pm * BM + wr * 64 + fr, col0 = u.pn * BM + wc * 32 + 8 * fq;
#pragma unroll
        for (int ai = 0; ai < 2; ++ai)
#pragma unroll
            for (int m = 0; m < 4; ++m) { const size_t off = (size_t)(row0 + ai * HALF + m * 16) * 1024 + col0;
#pragma unroll
                for (int bj = 0; bj < 2; ++bj) { const u32x2 g = __builtin_nontemporal_load((const u32x2*)(ga8 + off + bj * HALF));
                    f32x4 v0 = acc[ai][bj][m][0] * (1.0f / 255.0f), v1 = acc[ai][bj][m][1] * (1.0f / 255.0f);
                    v0[0] *= ub0(g.x); v0[1] *= ub1(g.x); v0[2] *= ub2(g.x); v0[3] *= ub3(g.x); v1[0] *= ub0(g.y); v1[1] *= ub1(g.y); v1[2] *= ub2(g.y); v1[3] *= ub3(g.y);
                    *(u32x4*)(p1 + off + bj * HALF) = pack8(v0, v1); } }
    }
};
struct EpiMix2 {
    static constexpr bool PERM = true, AFTER_DRAIN = false;
    const unsigned char* gb8; const bf16_t* p1; bf16_t* mix;
    __device__ __forceinline__ void operator()(const f32x4 (&acc)[2][2][4][2], const Unit& u, int wr, int wc, int fr, int fq) const {
        typedef unsigned u32x2 __attribute__((ext_vector_type(2)));
        const int row0 = u.pm * BM + wr * 64 + fr, col0 = u.pn * BM + wc * 32 + 8 * fq;
#pragma unroll
        for (int ai = 0; ai < 2; ++ai)
#pragma unroll
            for (int m = 0; m < 4; ++m) { const size_t off = (size_t)(row0 + ai * HALF + m * 16) * 1024 + col0;
#pragma unroll
                for (int bj = 0; bj < 2; ++bj) { const u32x2 g = __builtin_nontemporal_load((const u32x2*)(gb8 + off + bj * HALF)); const u32x4 p = __builtin_nontemporal_load((const u32x4*)(p1 + off + bj * HALF));
                    f32x4 v0 = acc[ai][bj][m][0] * (1.0f / 255.0f), v1 = acc[ai][bj][m][1] * (1.0f / 255.0f);
                    v0[0] = v0[0] * ub0(g.x) + bflo(p.x); v0[1] = v0[1] * ub1(g.x) + bfhi(p.x); v0[2] = v0[2] * ub2(g.x) + bflo(p.y); v0[3] = v0[3] * ub3(g.x) + bfhi(p.y);
                    v1[0] = v1[0] * ub0(g.y) + bflo(p.z); v1[1] = v1[1] * ub1(g.y) + bfhi(p.z); v1[2] = v1[2] * ub2(g.y) + bflo(p.w); v1[3] = v1[3] * ub3(g.y) + bfhi(p.w);
                    *(u32x4*)(mix + off + bj * HALF) = pack8(v0, v1); } }
    }
};
struct EpiWo {
    static constexpr bool PERM = true, AFTER_DRAIN = false;
    bf16_t* x1; float* ss;
    __device__ __forceinline__ void operator()(const f32x4 (&acc)[2][2][4][2], const Unit& u, int wr, int wc, int fr, int fq) const {
        const int row0 = u.pm * BM + wr * 64 + fr, col0 = u.pn * BM + wc * 32 + 8 * fq;
#pragma unroll
        for (int ai = 0; ai < 2; ++ai)
#pragma unroll
            for (int m = 0; m < 4; ++m) { const int row = row0 + ai * HALF + m * 16; const size_t off = (size_t)row * 1024 + col0;
                float q = 0.f;
#pragma unroll
                for (int bj = 0; bj < 2; ++bj) { const u32x4 xw = *(const u32x4*)(x1 + off + bj * HALF);
                    f32x4 v0 = acc[ai][bj][m][0], v1 = acc[ai][bj][m][1];
                    v0[0] += bflo(xw.x); v0[1] += bfhi(xw.x); v0[2] += bflo(xw.y); v0[3] += bfhi(xw.y); v1[0] += bflo(xw.z); v1[1] += bfhi(xw.z); v1[2] += bflo(xw.w); v1[3] += bfhi(xw.w);
                    q += (v0[0] * v0[0] + v0[1] * v0[1]) + (v0[2] * v0[2] + v0[3] * v0[3]) + (v1[0] * v1[0] + v1[1] * v1[1]) + (v1[2] * v1[2] + v1[3] * v1[3]);
                    *(u32x4*)(x1 + off + bj * HALF) = pack8(v0, v1); }
                q += __shfl_xor(q, 16); q += __shfl_xor(q, 32);
                if (fq == 0) ss[(size_t)row * 16 + u.pn * 4 + wc] = q; }
    }
};
template <int CTRL> __device__ __forceinline__ float dpp_z(float src) { return __builtin_bit_cast(float, __builtin_amdgcn_update_dpp(0, __builtin_bit_cast(int, src), CTRL, 0xf, 0xf, true)); }
template <int CTRL> __device__ __forceinline__ float dpp_mov(float old, float src) { return __builtin_bit_cast(float, __builtin_amdgcn_update_dpp(__builtin_bit_cast(int, old), __builtin_bit_cast(int, src), CTRL, 0xf, 0xf, false)); }
struct EpiUpAct {
    static constexpr bool PERM = true, AFTER_DRAIN = false;
    bf16_t* act; const float* ss; const float* cw; const float* cb; const float* sconv; float* cp; float* uvs; float* ul; float* sconv_out; int mp; __amdgpu_buffer_rsrc_t wsr; unsigned o_act, o_cp, o_uvs, o_ul;
    const PG8_LAS float* rsl;
    __device__ __forceinline__ void operator()(const f32x4 (&acc)[2][2][4][2], const Unit& u, int wr, int wc, int fr, int fq) const {
        if (u.pm * BM >= mp) body<true>(acc, u, wr, wc, fr, fq); else body<false>(acc, u, wr, wc, fr, fq);
    }
    template <bool sample>
    __device__ __forceinline__ void body(const f32x4 (&acc)[2][2][4][2], const Unit& u, int wr, int wc, int fr, int fq) const {
        if constexpr (sample) body_sample(acc, u, wr, wc, fr, fq); else body_prompt(acc, u, wr, wc, fr, fq);
    }
    __device__ __forceinline__ void body_prompt(const f32x4 (&acc)[2][2][4][2], const Unit& u, int wr, int wc, int fr, int fq) const {
        typedef float f32x2 __attribute__((ext_vector_type(2)));
        const int col0 = u.pn * 128 + wc * 32 + 8 * fq;
        f32x2 W0[4], W1[4], W2[4], BB[4], W1m[4], W0m[4];
        { const f32x2* pa = (const f32x2*)(cw + col0); const f32x2* pb = (const f32x2*)(cw + 2816 + col0); const f32x2* pc = (const f32x2*)(cw + 2 * 2816 + col0); const f32x2* pd = (const f32x2*)(cb + col0);
          const f32x2 z2 = {0.f, 0.f};
#pragma unroll
          for (int q = 0; q < 4; ++q) { W0[q] = pa[q]; W1[q] = pb[q]; W2[q] = pc[q]; BB[q] = pd[q]; W1m[q] = (fr == 0) ? W1[q] : z2; W0m[q] = (fr < 2) ? W0[q] : z2; } }
        const f32x2 K1 = {-2.8853900817779268f * 0.035677408136300125f, -2.8853900817779268f * 0.035677408136300125f}, K0 = {-2.8853900817779268f * 0.7978845608028654f, -2.8853900817779268f * 0.7978845608028654f};
        const PG8_LAS float* rs = rsl + (-1 - u.kz) * 256;
#pragma unroll
        for (int ai = 0; ai < 2; ++ai) { const int rb = u.pm * BM + ai * HALF + wr * 64, blk = rb >> 6;
            f32x2 XM[4];
#pragma unroll
            for (int m = 0; m < 4; ++m) { const int row = rb + 16 * m + fr; const float s = rs[row & 255];
                f32x2 X[4], U[4], C[4], O[4];
#pragma unroll
                for (int q = 0; q < 4; ++q) { const f32x4 av = acc[ai][0][m][q >> 1], uv4 = acc[ai][1][m][q >> 1];
                    X[q] = (f32x2){av[2 * (q & 1)], av[2 * (q & 1) + 1]} * s; U[q] = (f32x2){uv4[2 * (q & 1)], uv4[2 * (q & 1) + 1]} * s; }
#pragma unroll
                for (int q = 0; q < 4; ++q) {
                    f32x2 c = __builtin_elementwise_fma(W2[q], X[q], BB[q]);
                    c = __builtin_elementwise_fma((f32x2){dpp_z<0x111>(X[q][0]), dpp_z<0x111>(X[q][1])}, W1[q], c);
                    c = __builtin_elementwise_fma((f32x2){dpp_z<0x112>(X[q][0]), dpp_z<0x112>(X[q][1])}, W0[q], c);
                    if (m > 0) { c = __builtin_elementwise_fma((f32x2){dpp_z<0x121>(XM[q][0]), dpp_z<0x121>(XM[q][1])}, W1m[q], c);
                                 c = __builtin_elementwise_fma((f32x2){dpp_z<0x122>(XM[q][0]), dpp_z<0x122>(XM[q][1])}, W0m[q], c); }
                    C[q] = c;
                    const f32x2 nz = c * __builtin_elementwise_fma(c * c, K1, K0);
                    const f32x2 den = (f32x2){__builtin_amdgcn_exp2f(nz[0]), __builtin_amdgcn_exp2f(nz[1])} + 1.0f;
                    O[q] = (c * U[q]) * (f32x2){__builtin_amdgcn_rcpf(den[0]), __builtin_amdgcn_rcpf(den[1])}; XM[q] = X[q]; }
                { const f32x4 oa = {O[0][0], O[0][1], O[1][0], O[1][1]}, ob = {O[2][0], O[2][1], O[3][0], O[3][1]};
                  st_wt(wsr, o_act + (unsigned)(((size_t)row * 2816 + col0) * 2), pack8(oa, ob)); }
                if (m == 0 && fr < 2) { const unsigned so = (unsigned)((((size_t)blk * 2 + fr) * 2816 + col0) * 4);
                    st_wt(wsr, o_cp + so, (f32x4){C[0][0], C[0][1], C[1][0], C[1][1]}); st_wt(wsr, o_cp + so + 16, (f32x4){C[2][0], C[2][1], C[3][0], C[3][1]});
                    st_wt(wsr, o_uvs + so, (f32x4){U[0][0], U[0][1], U[1][0], U[1][1]}); st_wt(wsr, o_uvs + so + 16, (f32x4){U[2][0], U[2][1], U[3][0], U[3][1]}); }
                if (m == 3 && fr >= 14) { const unsigned so = (unsigned)((((size_t)blk * 2 + (fr - 14)) * 2816 + col0) * 4);
                    st_wt(wsr, o_ul + so, (f32x4){X[0][0], X[0][1], X[1][0], X[1][1]}); st_wt(wsr, o_ul + so + 16, (f32x4){X[2][0], X[2][1], X[3][0], X[3][1]}); } } }
    }
    __device__ __forceinline__ void body_sample(const f32x4 (&acc)[2][2][4][2], const Unit& u, int wr, int wc, int fr, int fq) const {
        constexpr bool sample = true;
        const int col0 = u.pn * 128 + wc * 32 + 8 * fq;
        float w0[8], w1[8], w2[8], bb[8];
        { const f32x4 a0 = *(const f32x4*)(cw + col0), a1 = *(const f32x4*)(cw + col0 + 4), b0 = *(const f32x4*)(cw + 2816 + col0), b1 = *(const f32x4*)(cw + 2816 + col0 + 4);
          const f32x4 c0 = *(const f32x4*)(cw + 2 * 2816 + col0), c1 = *(const f32x4*)(cw + 2 * 2816 + col0 + 4), d0 = *(const f32x4*)(cb + col0), d1 = *(const f32x4*)(cb + col0 + 4);
#pragma unroll
          for (int e = 0; e < 4; ++e) { w0[e] = a0[e]; w0[4 + e] = a1[e]; w1[e] = b0[e]; w1[4 + e] = b1[e]; w2[e] = c0[e]; w2[4 + e] = c1[e]; bb[e] = d0[e]; bb[4 + e] = d1[e]; } }
        float w1m[8], w0m[8];
#pragma unroll
        for (int e = 0; e < 8; ++e) { w1m[e] = (fr == 0) ? w1[e] : 0.f; w0m[e] = (fr < 2) ? w0[e] : 0.f; }
#pragma unroll
        for (int ai = 0; ai < 2; ++ai) { const int rb = u.pm * BM + ai * HALF + wr * 64, blk = rb >> 6;
            float xm1[8];
#pragma unroll
            for (int e = 0; e < 8; ++e) xm1[e] = 0.f;
#pragma unroll
            for (int m = 0; m < 4; ++m) { const int row = rb + 16 * m + fr; float s;
                if (sample) { const f32x4* sp = (const f32x4*)(ss + (size_t)row * 16);
                    const f32x4 s0 = sp[0], s1 = sp[1], s2 = sp[2], s3 = sp[3]; const f32x4 st = (s0 + s1) + (s2 + s3);
                    s = __builtin_amdgcn_rsqf(((st[0] + st[1]) + (st[2] + st[3])) * (1.0f / 1024.0f) + 1e-6f); }
                else s = rsl[(-1 - u.kz) * 256 + (row & 255)];
                float x[8], uvv[8], p1[8], p2[8], c8[8], o8[8];
#pragma unroll
                for (int e = 0; e < 4; ++e) { x[e] = acc[ai][0][m][0][e] * s; x[4 + e] = acc[ai][0][m][1][e] * s; uvv[e] = acc[ai][1][m][0][e] * s; uvv[4 + e] = acc[ai][1][m][1][e] * s; }
                if constexpr (sample) {
#pragma unroll
                for (int e = 0; e < 8; ++e) { const float t1 = dpp_mov<0x121>(0.f, xm1[e]), t2 = dpp_mov<0x122>(0.f, xm1[e]);
                    p1[e] = dpp_mov<0x111>(t1, x[e]); p2[e] = dpp_mov<0x112>(t2, x[e]); }
                }
                if (sample) { const int t = fr & 7;
                    if (t < 2) { const float* sc = sconv + (size_t)((row - mp) >> 3) * 2 * 2816 + col0;
#pragma unroll
                        for (int e = 0; e < 8; ++e) { const float c1v = sc[2816 + e]; if (t == 0) { p2[e] = sc[e]; p1[e] = c1v; } else p2[e] = c1v; } }
                    if (t >= 6) { float* so = sconv_out + ((size_t)((row - mp) >> 3) * 2 + (t - 6)) * 2816 + col0; *(f32x4*)so = (f32x4){x[0], x[1], x[2], x[3]}; *(f32x4*)(so + 4) = (f32x4){x[4], x[5], x[6], x[7]}; } }
#pragma unroll
                for (int e = 0; e < 8; ++e) { float c;
                    if constexpr (sample) c = __builtin_fmaf(w2[e], x[e], __builtin_fmaf(w1[e], p1[e], __builtin_fmaf(w0[e], p2[e], bb[e])));
                    else { c = __builtin_fmaf(w2[e], x[e], bb[e]); c = __builtin_fmaf(dpp_z<0x111>(x[e]), w1[e], c); c = __builtin_fmaf(dpp_z<0x112>(x[e]), w0[e], c);
                        if (m > 0) { c = __builtin_fmaf(dpp_z<0x121>(xm1[e]), w1m[e], c); c = __builtin_fmaf(dpp_z<0x122>(xm1[e]), w0m[e], c); } }
                    c8[e] = c;
                    const float nz = c * __builtin_fmaf(c * c, -2.8853900817779268f * 0.035677408136300125f, -2.8853900817779268f * 0.7978845608028654f);
                    o8[e] = (c * uvv[e]) * __builtin_amdgcn_rcpf(1.0f + __builtin_amdgcn_exp2f(nz)); xm1[e] = x[e]; }
                f32x4 oa = {o8[0], o8[1], o8[2], o8[3]}, ob = {o8[4], o8[5], o8[6], o8[7]};
                *(u32x4*)(act + (size_t)row * 2816 + col0) = pack8(oa, ob);
                if (!sample) {
                    if (m == 0 && fr < 2) { float* cpp = cp + ((size_t)blk * 2 + fr) * 2816 + col0; float* uvp = uvs + ((size_t)blk * 2 + fr) * 2816 + col0;
                        *(f32x4*)cpp = (f32x4){c8[0], c8[1], c8[2], c8[3]}; *(f32x4*)(cpp + 4) = (f32x4){c8[4], c8[5], c8[6], c8[7]};
                        *(f32x4*)uvp = (f32x4){uvv[0], uvv[1], uvv[2], uvv[3]}; *(f32x4*)(uvp + 4) = (f32x4){uvv[4], uvv[5], uvv[6], uvv[7]}; }
                    if (m == 3 && fr >= 14) { float* ulp = ul + ((size_t)blk * 2 + (fr - 14)) * 2816 + col0;
                        *(f32x4*)ulp = (f32x4){x[0], x[1], x[2], x[3]}; *(f32x4*)(ulp + 4) = (f32x4){x[4], x[5], x[6], x[7]}; } } } }
    }
};
struct EpiDown {
    static constexpr bool PERM = true, AFTER_DRAIN = false;
    bf16_t* x1; float* ss; float* slab; int tail_row0;
    __device__ __forceinline__ void operator()(const f32x4 (&acc)[2][2][4][2], const Unit& u, int wr, int wc, int fr, int fq) const {
        const int row0 = u.pm * BM + wr * 64 + fr, col0 = u.pn * BM + wc * 32 + 8 * fq;
        if (u.kz >= 0) { float* sl = slab + ((size_t)u.kz * 1024 - tail_row0) * 1024;
#pragma unroll
            for (int ai = 0; ai < 2; ++ai)
#pragma unroll
                for (int m = 0; m < 4; ++m) { float* rp = sl + (size_t)(row0 + ai * HALF + m * 16) * 1024 + col0;
#pragma unroll
                    for (int bj = 0; bj < 2; ++bj) { *(f32x4*)(rp + bj * HALF) = acc[ai][bj][m][0]; *(f32x4*)(rp + bj * HALF + 4) = acc[ai][bj][m][1]; } }
            return; }
#pragma unroll
        for (int ai = 0; ai < 2; ++ai)
#pragma unroll
            for (int m = 0; m < 4; ++m) { const int row = row0 + ai * HALF + m * 16; const size_t off = (size_t)row * 1024 + col0; float q = 0.f;
#pragma unroll
                for (int bj = 0; bj < 2; ++bj) { const u32x4 b = *(const u32x4*)(x1 + off + bj * HALF);
                    f32x4 v0 = acc[ai][bj][m][0], v1 = acc[ai][bj][m][1];
                    v0[0] += bflo(b.x); v0[1] += bfhi(b.x); v0[2] += bflo(b.y); v0[3] += bfhi(b.y); v1[0] += bflo(b.z); v1[1] += bfhi(b.z); v1[2] += bflo(b.w); v1[3] += bfhi(b.w);
                    q += (v0[0] * v0[0] + v0[1] * v0[1]) + (v0[2] * v0[2] + v0[3] * v0[3]) + (v1[0] * v1[0] + v1[1] * v1[1]) + (v1[2] * v1[2] + v1[3] * v1[3]);
                    *(u32x4*)(x1 + off + bj * HALF) = pack8(v0, v1); }
                q += __shfl_xor(q, 16); q += __shfl_xor(q, 32);
                if (fq == 0) __hip_atomic_store(ss + (size_t)row * 16 + u.pn * 4 + wc, q, __ATOMIC_RELAXED, __HIP_MEMORY_SCOPE_AGENT); }
    }
};

template <class Epi, class Sched, bool ALIGN_EPI = false, bool SP2 = false>
__device__ __forceinline__ void gemm_phase(PG8_LAS unsigned char* lds, const Gemm g, const Sched& S, const Epi& E) {
    int tid_ = threadIdx.x; asm volatile("" : "+v"(tid_));
    const int tid = tid_, wid = __builtin_amdgcn_readfirstlane(tid >> 6), lane = tid & 63, wr = wid >> 2, wc = wid & 3, fr = lane & 15, fq = lane >> 4;
    const int K = g.K;
    unsigned voffA[2], voffB[2];
#pragma unroll
    for (int i = 0; i < 2; ++i) { int R, C; stage_rc(tid * 16 + i * 8192, R, C); const int Rb = Epi::PERM ? ((R & ~31) + perm32(R & 31)) : R;
        voffA[i] = (unsigned)(R * g.lda + C) * 2u; voffB[i] = (unsigned)(Rb * g.ldb + C) * 2u; }
    const size_t kstep = (size_t)(BK * 2);
    const size_t hstepA = (size_t)HALF * g.lda * 2, hstepB = (size_t)g.bhalf_rows * g.ldb * 2;
    const size_t tstepA = (size_t)BM * g.lda * 2, tstepB = (size_t)g.btile_rows * g.ldb * 2;
    const unsigned ldsw = (unsigned)wid * 1024u;
    const int aoff = lds_byte(wr * 64 + fr, fq * 8), boff = lds_byte(wc * 32 + fr, fq * 8);
#define PG8_SA(b, h) (((b) * 2 + (h)) * HTB)
#define PG8_SB(b, h) ((4 + (b) * 2 + (h)) * HTB)
#define PG8_STAGE(bufoff, gbase, voff) do { _Pragma("unroll") for (int _i = 0; _i < 2; ++_i) \
        __builtin_amdgcn_global_load_lds((const unsigned*)((const char*)(gbase) + (voff)[_i]), (PG8_LAS unsigned*)(lds + (bufoff) + ldsw + _i * 8192), 16, 0, 0); } while (0)
#define PG8_LDA(dst, b, h) do { _Pragma("unroll") for (int m = 0; m < 4; ++m) _Pragma("unroll") for (int k = 0; k < 2; ++k) dst[m][k] = *(const PG8_LAS bf16x8*)(lds + PG8_SA(b, h) + aoff + m * 2048 + k * 1024); } while (0)
#define PG8_LDB(dst, b, h) do { _Pragma("unroll") for (int n = 0; n < 2; ++n) _Pragma("unroll") for (int k = 0; k < 2; ++k) dst[n][k] = *(const PG8_LAS bf16x8*)(lds + PG8_SB(b, h) + boff + n * 2048 + k * 1024); } while (0)
#define PG8_MMA(ai, bj, At, Bt) do { __builtin_amdgcn_s_setprio(1); _Pragma("unroll") for (int m = 0; m < 4; ++m) _Pragma("unroll") for (int n = 0; n < 2; ++n) _Pragma("unroll") for (int k = 0; k < 2; ++k) \
        acc[ai][bj][m][n] = __builtin_amdgcn_mfma_f32_16x16x32_bf16(Bt[n][k], At[m][k], acc[ai][bj][m][n], 0, 0, 0); __builtin_amdgcn_s_setprio(0); } while (0)
#define PG8_WAIT_V(n) asm volatile("s_waitcnt vmcnt(" #n ")" ::: "memory")
#define PG8_WAIT_L(n) asm volatile("s_waitcnt lgkmcnt(" #n ")" ::: "memory")
#define PG8_BAR __builtin_amdgcn_s_barrier()
#define PG8_SCHED __builtin_amdgcn_sched_barrier(0)
    Unit cur, nxt; int ui = 0;
    if (!S.next(0, cur)) return;
    f32x4 acc[2][2][4][2];
#pragma unroll
    for (int a = 0; a < 2; ++a)
#pragma unroll
        for (int b = 0; b < 2; ++b)
#pragma unroll
            for (int m = 0; m < 4; ++m)
#pragma unroll
                for (int n = 0; n < 2; ++n) acc[a][b][m][n] = (f32x4){0.f, 0.f, 0.f, 0.f};
    bf16x8 At[4][2], B0[2][2], B1[2][2];
#define PG8_UA(u) ((const char*)g.A + (size_t)(u).pm * tstepA + ((u).kz > 0 ? (size_t)(u).kz * g.ksplit * 2 : 0))
#define PG8_UB(u) ((const char*)g.Bt + (size_t)(u).pn * tstepB + ((u).kz > 0 ? (size_t)(u).kz * g.ksplit * 2 : 0))
    const char* cA = PG8_UA(cur); const char* cB = PG8_UB(cur);
    S.a_ready(cur);
    if constexpr (SP2) {
        PG8_STAGE(PG8_SB(0, 0), cB, voffB); PG8_STAGE(PG8_SB(0, 1), cB + hstepB, voffB); PG8_STAGE(PG8_SA(0, 0), cA, voffA); PG8_STAGE(PG8_SA(0, 1), cA + hstepA, voffA);
        if (wr == 1) PG8_BAR;
        PG8_WAIT_V(2); PG8_BAR;
        PG8_STAGE(PG8_SB(1, 0), cB + kstep, voffB); PG8_STAGE(PG8_SA(1, 0), cA + kstep, voffA); PG8_STAGE(PG8_SB(1, 1), cB + hstepB + kstep, voffB);
        PG8_WAIT_V(6); PG8_BAR;
    } else {
        PG8_STAGE(PG8_SB(0, 0), cB, voffB); PG8_STAGE(PG8_SA(0, 0), cA, voffA); PG8_STAGE(PG8_SB(0, 1), cB + hstepB, voffB); PG8_STAGE(PG8_SA(0, 1), cA + hstepA, voffA);
        if (wr == 1) PG8_BAR;
        PG8_WAIT_V(4); PG8_BAR;
        PG8_STAGE(PG8_SB(1, 0), cB + kstep, voffB); PG8_STAGE(PG8_SA(1, 0), cA + kstep, voffA); PG8_STAGE(PG8_SB(1, 1), cB + hstepB + kstep, voffB);
        PG8_WAIT_V(6); PG8_BAR;
    }
    for (;;) {
        const bool has_next = S.next(ui + 1, nxt);
        const char* nA = has_next ? PG8_UA(nxt) : cA; const char* nB = has_next ? PG8_UB(nxt) : cB;
        const int nt = ((cur.kz >= 0) ? g.ksplit : K) / BK;
        for (int t = 0; t < nt; t += 2) {
            const bool last = (t == nt - 2);
            const char* a1 = cA + (size_t)(t + 1) * kstep;
            const char* a2 = last ? nA : cA + (size_t)(t + 2) * kstep; const char* b2 = last ? nB : cB + (size_t)(t + 2) * kstep;
            const char* a3 = a2 + kstep; const char* b3 = b2 + kstep;
            if (last && has_next) S.a_ready(nxt);
            if constexpr (SP2) {
            PG8_LDB(B0, 0, 0); PG8_LDB(B1, 0, 1); PG8_SCHED; PG8_LDA(At, 0, 0); PG8_STAGE(PG8_SA(1, 1), a1 + hstepA, voffA);
            PG8_WAIT_V(8); PG8_WAIT_L(0); PG8_BAR; PG8_MMA(0, 0, At, B0); PG8_MMA(0, 1, At, B1); PG8_BAR; PG8_SCHED;
            PG8_LDA(At, 0, 1); PG8_STAGE(PG8_SB(0, 0), b2, voffB); PG8_STAGE(PG8_SB(0, 1), b2 + hstepB, voffB); PG8_STAGE(PG8_SA(0, 0), a2, voffA);
            PG8_WAIT_V(8); PG8_WAIT_L(0); PG8_BAR; PG8_MMA(1, 0, At, B0); PG8_MMA(1, 1, At, B1); PG8_BAR; PG8_SCHED;
            PG8_LDB(B0, 1, 0); PG8_LDB(B1, 1, 1); PG8_SCHED; PG8_LDA(At, 1, 0); PG8_STAGE(PG8_SA(0, 1), a2 + hstepA, voffA);
            PG8_WAIT_V(8); PG8_WAIT_L(0); PG8_BAR; PG8_MMA(0, 0, At, B0); PG8_MMA(0, 1, At, B1); PG8_BAR; PG8_SCHED;
            PG8_LDA(At, 1, 1); PG8_STAGE(PG8_SB(1, 0), b3, voffB); PG8_STAGE(PG8_SB(1, 1), b3 + hstepB, voffB); PG8_STAGE(PG8_SA(1, 0), a3, voffA);
            PG8_WAIT_V(8); PG8_WAIT_L(0); PG8_BAR; PG8_MMA(1, 0, At, B0); PG8_MMA(1, 1, At, B1); PG8_BAR; PG8_SCHED;
            } else {
            PG8_LDB(B0, 0, 0); PG8_SCHED; PG8_LDA(At, 0, 0); PG8_STAGE(PG8_SA(1, 1), a1 + hstepA, voffA);
            PG8_WAIT_L(8); PG8_BAR; PG8_WAIT_L(0); PG8_MMA(0, 0, At, B0); PG8_BAR; PG8_SCHED;
            PG8_LDB(B1, 0, 1); PG8_STAGE(PG8_SB(0, 0), b2, voffB);
            PG8_BAR; PG8_WAIT_L(0); PG8_MMA(0, 1, At, B1); PG8_BAR;
            PG8_LDA(At, 0, 1); PG8_STAGE(PG8_SA(0, 0), a2, voffA);
            PG8_BAR; PG8_WAIT_L(0); PG8_MMA(1, 0, At, B0); PG8_BAR; PG8_SCHED;
            PG8_STAGE(PG8_SB(0, 1), b2 + hstepB, voffB);
            PG8_WAIT_V(6); PG8_BAR; PG8_MMA(1, 1, At, B1); PG8_BAR;
            PG8_LDB(B0, 1, 0); PG8_SCHED; PG8_LDA(At, 1, 0); PG8_STAGE(PG8_SA(0, 1), a2 + hstepA, voffA);
            PG8_WAIT_L(8); PG8_BAR; PG8_WAIT_L(0); PG8_MMA(0, 0, At, B0); PG8_BAR; PG8_SCHED;
            PG8_LDB(B1, 1, 1); PG8_STAGE(PG8_SB(1, 0), b3, voffB);
            PG8_BAR; PG8_WAIT_L(0); PG8_MMA(0, 1, At, B1); PG8_BAR;
            PG8_LDA(At, 1, 1); PG8_STAGE(PG8_SA(1, 0), a3, voffA);
            PG8_BAR; PG8_WAIT_L(0); PG8_MMA(1, 0, At, B0); PG8_BAR; PG8_SCHED;
            PG8_STAGE(PG8_SB(1, 1), b3 + hstepB, voffB);
            PG8_WAIT_V(6); PG8_BAR; PG8_MMA(1, 1, At, B1); PG8_BAR;
            }
        }
        if constexpr (ALIGN_EPI) { if (wr == 0) PG8_BAR; }
        if constexpr (!Epi::AFTER_DRAIN) { E(acc, cur, wr, wc, fr, fq); S.done(cur); }
        if (!has_next) break;
#pragma unroll
        for (int a = 0; a < 2; ++a)
#pragma unroll
            for (int b = 0; b < 2; ++b)
#pragma unroll
                for (int m = 0; m < 4; ++m)
#pragma unroll
                    for (int n = 0; n < 2; ++n) acc[a][b][m][n] = (f32x4){0.f, 0.f, 0.f, 0.f};
        cur = nxt; cA = nA; cB = nB; ++ui;
        if constexpr (ALIGN_EPI) { if (wr == 1) PG8_BAR; }
    }
    PG8_WAIT_V(0);
    if constexpr (!ALIGN_EPI) { if (wr == 0) PG8_BAR; }
    PG8_BAR;
    if constexpr (Epi::AFTER_DRAIN) { E.fused(acc, cur, wr, wc, fr, fq, lds, wid, lane); S.done(cur); }
#undef PG8_UA
#undef PG8_UB
#undef PG8_SA
#undef PG8_SB
#undef PG8_STAGE
#undef PG8_LDA
#undef PG8_LDB
#undef PG8_MMA
#undef PG8_WAIT_V
#undef PG8_WAIT_L
#undef PG8_BAR
#undef PG8_SCHED
}
}

#define GAS __attribute__((address_space(1)))
#define LAS __attribute__((address_space(3)))
typedef unsigned short bf16;
typedef unsigned v4u __attribute__((ext_vector_type(4)));
typedef float f32x4 __attribute__((ext_vector_type(4)));
typedef short bf16x8 __attribute__((ext_vector_type(8)));
typedef GAS unsigned gu32;
typedef GAS unsigned long long gu64;
#define RLX_AGENT __ATOMIC_RELAXED, __HIP_MEMORY_SCOPE_AGENT
#define LDS_WAIT() asm volatile("s_waitcnt lgkmcnt(0)" ::: "memory")
#define VM_WAIT() asm volatile("s_waitcnt vmcnt(0)" ::: "memory")
__device__ __forceinline__ unsigned long long rt() { return __builtin_amdgcn_s_memrealtime(); }
__device__ __forceinline__ unsigned f2bf(float f) { unsigned u = __builtin_bit_cast(unsigned, f); return (u + 0x7fffu + ((u >> 16) & 1u)) >> 16; }
__device__ __forceinline__ unsigned pk2(float lo, float hi) { return f2bf(lo) | (f2bf(hi) << 16); }

#define XB_TMO      128
#define XB_XCNT(j)  (256  + 64 * (j))
#define XB_XSUB(j)  (1280 + 64 * (j))
#define XB_XGEN(j)  (2304 + 64 * (j))
#define XB_TOP      3328
#define XB_TOPGEN   3392
#define XCD_BAR_WORDS 3456
#define XB_SPIN_CAP (1u << 18)

__device__ __forceinline__ unsigned xb_ld(unsigned* p)              { return __hip_atomic_load(p, __ATOMIC_RELAXED, __HIP_MEMORY_SCOPE_AGENT); }
__device__ __forceinline__ unsigned xb_add(unsigned* p, unsigned v) { return __hip_atomic_fetch_add(p, v, __ATOMIC_RELAXED, __HIP_MEMORY_SCOPE_AGENT); }
__device__ __forceinline__ unsigned xb_xcc_id() { return (unsigned)__builtin_amdgcn_s_getreg((3 << 11) | 20) & 0xFu; }
#define XB_SPIN(cond, bar) do { unsigned _sp = 0; while (cond) { __builtin_amdgcn_s_sleep(1); \
    if ((++_sp & 255u) == 0u) { if (xb_ld(&(bar)[XB_TMO])) break; if (_sp > XB_SPIN_CAP) { atomicAdd(&(bar)[XB_TMO], 1u); break; } } } } while (0)

struct XcdBarrier {
    unsigned* bar; unsigned x;
    volatile LAS unsigned* st;
};

__device__ __forceinline__ XcdBarrier xcd_barrier_post(unsigned* bar, volatile LAS unsigned* st) {
    XcdBarrier b; b.bar = bar; b.x = xb_xcc_id(); b.st = st;
    if (threadIdx.x == 0) (void)xb_add(&bar[XB_XCNT(b.x)], 1u);
    return b;
}
__device__ __forceinline__ void xcd_barrier_complete(unsigned* bar, unsigned x, unsigned& nloc, unsigned& nx) {
    const unsigned G = gridDim.x * gridDim.y * gridDim.z;
    unsigned sum, cnt, mine, sp = 0u;
    for (;;) {
        sum = 0u; cnt = 0u; mine = 0u;
#pragma unroll
        for (unsigned j = 0; j < 16; ++j) { const unsigned c = xb_ld(&bar[XB_XCNT(j)]); sum += c; cnt += (c > 0u) ? 1u : 0u; mine = (j == x) ? c : mine; }
        if (sum == G) break;
        __builtin_amdgcn_s_sleep(1);
        if ((++sp & 255u) == 0u) { if (xb_ld(&bar[XB_TMO])) break; if (sp > XB_SPIN_CAP) { atomicAdd(&bar[XB_TMO], 1u); break; } }
    }
    nloc = mine > 0u ? mine : 1u; nx = cnt > 0u ? cnt : 1u;
}

__device__ __forceinline__ void xcd_barrier(const XcdBarrier& b) {
    asm volatile("s_waitcnt vmcnt(0)" ::: "memory");
    __syncthreads();
    if (threadIdx.x == 0) {
        unsigned* bar = b.bar;
        __builtin_amdgcn_s_waitcnt(0);
        unsigned nloc = b.st[0], nx = b.st[1];
        if (nloc == 0u) { xcd_barrier_complete(bar, b.x, nloc, nx); b.st[0] = nloc; b.st[1] = nx; }
        const unsigned old = xb_add(&bar[XB_XSUB(b.x)], 1u);
        const unsigned gen = old / nloc;
        if (old + 1u == (gen + 1u) * nloc) {
            __builtin_amdgcn_fence(__ATOMIC_RELEASE, "agent");
            asm volatile("s_waitcnt vmcnt(0)" ::: "memory");
            const unsigned og = xb_add(&bar[XB_TOP], 1u);
            const unsigned tg = og / nx;
            if (og + 1u == (tg + 1u) * nx) xb_add(&bar[XB_TOPGEN], 1u);
            else XB_SPIN(xb_ld(&bar[XB_TOPGEN]) == tg, bar);
            __builtin_amdgcn_fence(__ATOMIC_ACQUIRE, "agent");
            xb_add(&bar[XB_XGEN(b.x)], 1u);
            asm volatile("s_waitcnt vmcnt(0)" ::: "memory");
        } else {
            XB_SPIN(xb_ld(&bar[XB_XGEN(b.x)]) == gen, bar);
            __builtin_amdgcn_fence(__ATOMIC_ACQUIRE, "agent");
            asm volatile("s_waitcnt vmcnt(0)" ::: "memory");
        }
    }
    __syncthreads();
}


constexpr int NWAVES = 8;
constexpr int DM = 1024, SEQ = 2048, NB = 16, DECB = 128, DECT = 8;
constexpr int MP = NB * SEQ, MS = DECB * DECT, M = MP + MS;
constexpr int QKVW = 768, RWS = 1792, INC = 4608, DFF = 2816, RW = 512;
constexpr int PAST = 16384;
#ifndef PROBE_SKIP
#define PROBE_SKIP 0
#endif
#ifndef PROBE_DUP
#define PROBE_DUP -1
#endif
#ifndef MK_N_LAUNCHES
#define MK_N_LAUNCHES 1
#endif
constexpr int NPH = 10;
constexpr int N_LAUNCHES = MK_N_LAUNCHES;

constexpr size_t MiB = 1u << 20;
constexpr size_t WS_CTL = 0, CTL_ZERO_BYTES = 1 * MiB;
constexpr size_t WS_WIN = 2 * MiB, WS_WPA = 11 * MiB, WS_WPB = 12 * MiB, WS_WO = 13 * MiB, WS_WUP = 15 * MiB, WS_WDN = 26 * MiB;
constexpr size_t WS_W2T = 39 * MiB, WS_A2T = WS_W2T + 65536, WS_G2T = WS_A2T + 65536;
constexpr size_t WS_RS1 = 32 * MiB, WS_SS2 = 33 * MiB, WS_SS3 = 36 * MiB;
constexpr size_t WS_BUFA = 40 * MiB;
constexpr size_t WS_QKV = 106 * MiB;
constexpr size_t WS_RWB = 156 * MiB;
constexpr size_t WS_GA = 272 * MiB;
constexpr size_t WS_GB = 338 * MiB;
constexpr size_t WS_GA8 = 371 * MiB;
constexpr size_t WS_ATT = 404 * MiB;
constexpr size_t WS_RWO = 437 * MiB;
constexpr size_t WS_ASIG = 470 * MiB;
constexpr size_t WS_UG = 330 * MiB;
constexpr size_t WS_UV = 142 * MiB;
constexpr size_t WS_CP = 106 * MiB, WS_UVS = 118 * MiB, WS_UL = 130 * MiB;
constexpr size_t WS_MIXS = 504 * MiB;
constexpr size_t WS_END = 507 * MiB;
constexpr int CW_TMO = 0, CW_CODE = 1, CW_SUB = 2048, CW_BAR = 4096, CW_DF = 8192;
constexpr size_t O_Y = 0, O_PWK = 34603008, O_PWV = 34865152, O_PSH = 35127296, O_PWKV = 35155968, O_PCONV = 35680256,
                 O_SWK = 35770368, O_SWV = 37867520, O_SSH = 39964672, O_SWKV = 40194048, O_SCONV = 44388352;
constexpr int RING_OFF = 0, RING_BYTES = 131072;
constexpr int LDSCTL_OFF = 162816, MISC_OFF = LDSCTL_OFF + 320;
constexpr int LDS_BYTES = 163840;

__device__ const unsigned char T5_BUCKET[128] = {0, 1, 2, 3, 4, 5, 6, 7, 8, 9, 10, 11, 12, 13, 14, 15, 16, 16, 16, 17, 17, 18, 18, 18, 19, 19, 19, 20, 20, 20, 20, 21, 21, 21, 21, 22, 22, 22, 22, 22, 23, 23, 23, 23, 23, 23, 24, 24, 24, 24, 24, 24, 25, 25, 25, 25, 25, 25, 25, 26, 26, 26, 26, 26, 26, 26, 26, 27, 27, 27, 27, 27, 27, 27, 27, 27, 27, 28, 28, 28, 28, 28, 28, 28, 28, 28, 28, 29, 29, 29, 29, 29, 29, 29, 29, 29, 29, 29, 29, 30, 30, 30, 30, 30, 30, 30, 30, 30, 30, 30, 30, 30, 30, 31, 31, 31, 31, 31, 31, 31, 31, 31, 31, 31, 31, 31, 31, 31};

struct Frame {
    LAS unsigned char* lds;
    volatile LAS unsigned* MISC;
    gu32* ctl;
    int tid, lane, wave;
    int vcu, G;
};
__device__ __forceinline__ float bf2f(bf16 h) { return __builtin_bit_cast(float, (unsigned)h << 16); }
__device__ __forceinline__ float bflo(unsigned w) { return __builtin_bit_cast(float, w << 16); }
__device__ __forceinline__ float bfhi(unsigned w) { return __builtin_bit_cast(float, w & 0xffff0000u); }
__device__ __forceinline__ float wave_sum(float v) {
    v += pg8::dpp_z<0xB1>(v); v += pg8::dpp_z<0x4E>(v); v += pg8::dpp_z<0x141>(v); v += pg8::dpp_z<0x140>(v);
    v += __shfl_xor(v, 16); v += __shfl_xor(v, 32);
    return v;
}
__device__ __forceinline__ float sigmoidf_(float x) { return 1.0f / (1.0f + __expf(-x)); }

struct Args { const float* in[31]; float* out; unsigned char* ws; int ph_lo, ph_hi, li, pad; };

__device__ __forceinline__ void p0_transpose_item(const float* W, const float* kscale, int K, int N, bf16* WT, LAS float* scr, int item, int lane) {
    const int nblk = N / 32, kb = item / nblk, nb = item % nblk, k0 = 64 * kb, n0 = 32 * nb;
    float wv[32];
#pragma unroll
    for (int i = 0; i < 32; ++i) wv[i] = W[(size_t)(k0 + 2 * i + (lane >> 5)) * N + n0 + (lane & 31)];
#pragma unroll
    for (int i = 0; i < 32; ++i) { const int kk = 2 * i + (lane >> 5); const float s = kscale ? kscale[k0 + kk] : 1.0f; scr[kk * 33 + (lane & 31)] = wv[i] * s; }
    LDS_WAIT(); asm volatile("" ::: "memory");
    const int c = lane & 7;
#pragma unroll
    for (int j = 0; j < 4; ++j) { const int n = (lane >> 3) + 8 * j; const LAS float* s = scr + (8 * c) * 33 + n;
        v4u o; o.x = pk2(s[0 * 33], s[1 * 33]); o.y = pk2(s[2 * 33], s[3 * 33]); o.z = pk2(s[4 * 33], s[5 * 33]); o.w = pk2(s[6 * 33], s[7 * 33]);
        *(GAS v4u*)(WT + (size_t)(n0 + n) * K + k0 + 8 * c) = o; }
    LDS_WAIT(); asm volatile("" ::: "memory");
}
__device__ __forceinline__ void p0_weights(Frame& F, const Args& a, int part, int gw, int NGW) {
    unsigned char* ws = a.ws;
    LAS float* scr = (LAS float*)(F.lds + RING_OFF + F.wave * 16384);
    constexpr int I_IN = (DM / 64) * (INC / 32), I_PA = (RW / 64) * (DM / 32), I_O = (DM / 64) * (DM / 32), I_UP = (DM / 64) * (2 * DFF / 32), I_DN = (DFF / 64) * (DM / 32);
    constexpr int I_L64 = (64 / 64) * (RW / 32), I_L128 = (128 / 64) * (RW / 32);
    if (part == 0) {
        constexpr int NITEMS = I_IN + I_PA + 2 * I_L64 + I_L128;
        for (int it = gw; it < NITEMS; it += NGW) { int r = it;
            if (r < I_IN) { p0_transpose_item(a.in[9], a.in[8], DM, INC, (bf16*)(ws + WS_WIN), scr, r, F.lane); continue; } r -= I_IN;
            if (r < I_PA) { p0_transpose_item(a.in[22], nullptr, RW, DM, (bf16*)(ws + WS_WPA), scr, r, F.lane); continue; } r -= I_PA;
            if (r < I_L64) { p0_transpose_item(a.in[13], nullptr, 64, RW, (bf16*)(ws + WS_W2T), scr, r, F.lane); continue; } r -= I_L64;
            if (r < I_L64) { p0_transpose_item(a.in[15], nullptr, 64, RW, (bf16*)(ws + WS_A2T), scr, r, F.lane); continue; } r -= I_L64;
            p0_transpose_item(a.in[16], nullptr, 128, RW, (bf16*)(ws + WS_G2T), scr, r, F.lane); }
    } else if (part == 1) {
        constexpr int NITEMS = I_PA + I_O;
        for (int it = gw; it < NITEMS; it += NGW) { int r = it;
            if (r < I_PA) { p0_transpose_item(a.in[23], nullptr, RW, DM, (bf16*)(ws + WS_WPB), scr, r, F.lane); continue; } r -= I_PA;
            p0_transpose_item(a.in[24], nullptr, DM, DM, (bf16*)(ws + WS_WO), scr, r, F.lane); }
    } else {
        constexpr int NITEMS = I_UP + I_DN;
        for (int it = gw; it < NITEMS; it += NGW) { int r = it;
            if (r < I_UP) { p0_transpose_item(a.in[26], a.in[25], DM, 2 * DFF, (bf16*)(ws + WS_WUP), scr, r, F.lane); continue; } r -= I_UP;
            p0_transpose_item(a.in[29], nullptr, DFF, DM, (bf16*)(ws + WS_WDN), scr, r, F.lane); }
    }
}
__device__ __forceinline__ void p0_prologue(Frame& F, const Args& a) {
    unsigned char* ws = a.ws;
    const int gw = F.vcu * NWAVES + F.wave, NGW = F.G * NWAVES;
    p0_weights(F, a, 0, gw, NGW);
    bf16* XB = (bf16*)(ws + WS_BUFA); float* RS1 = (float*)(ws + WS_RS1);
    for (int m0 = 4 * gw; m0 < M; m0 += 4 * NGW) {
        f32x4 v[4][4];
#pragma unroll
        for (int k = 0; k < 4; ++k) { const int m = m0 + k; const float* xrow = (m < MP) ? a.in[0] + (size_t)m * DM : a.in[1] + (size_t)(m - MP) * DM; const GAS f32x4* xr = (const GAS f32x4*)xrow + F.lane;
#pragma unroll
            for (int j = 0; j < 4; ++j) v[k][j] = __builtin_nontemporal_load(&xr[64 * j]); }
#pragma unroll
        for (int k = 0; k < 4; ++k) { const int m = m0 + k; float s_ = 0.f;
#pragma unroll
            for (int j = 0; j < 4; ++j) s_ += (v[k][j].x * v[k][j].x + v[k][j].y * v[k][j].y) + (v[k][j].z * v[k][j].z + v[k][j].w * v[k][j].w);
            s_ = wave_sum(s_);
            if (F.lane == 0) RS1[m] = 1.0f / sqrtf(s_ * (1.0f / DM) + 1e-6f);
            GAS unsigned long long* o8 = (GAS unsigned long long*)(XB + (size_t)m * DM) + F.lane;
#pragma unroll
            for (int j = 0; j < 4; ++j) o8[64 * j] = (unsigned long long)pk2(v[k][j].x, v[k][j].y) | ((unsigned long long)pk2(v[k][j].z, v[k][j].w) << 32); }
    }
}

constexpr int KPITCH = 72;
typedef float f32x16 __attribute__((ext_vector_type(16)));
typedef short v4i16_t __attribute__((ext_vector_type(4)));
typedef unsigned u32x2_t __attribute__((ext_vector_type(2)));
__device__ __forceinline__ v4i16_t lds_tr16(const LAS void* p) { return __builtin_amdgcn_ds_read_tr16_b64_v4i16((LAS v4i16_t*)p); }
typedef float f32x2_t __attribute__((ext_vector_type(2))); typedef __bf16 bf16x2_t __attribute__((ext_vector_type(2)));
__device__ __forceinline__ unsigned cvtpk(float lo, float hi) { f32x2_t v = {lo, hi}; bf16x2_t b = __builtin_convertvector(v, bf16x2_t); return __builtin_bit_cast(unsigned, b); }
constexpr float LOG2E = 1.4426950408889634f;
__device__ __forceinline__ void attn_block(const LAS bf16* Ks, const LAS bf16* Vs, const LAS float* biasM, const bf16x8 (&qf)[4], bf16* optr, int t0, int skip_lt, int ql, int gl, float sink2, int lane) {
    const int r32 = lane & 31, h = lane >> 5;
    f32x16 s[5];
    const LAS float* bt = biasM + gl * 192 + (160 + ql - 4 * h);
#pragma unroll
    for (int tt = 0; tt < 5; ++tt) {
        const int T = t0 + tt;
        if (T < skip_lt) {
#pragma unroll
            for (int r = 0; r < 16; ++r) s[tt][r] = -1e30f;
        } else {
            f32x16 acc;
#pragma unroll
            for (int r = 0; r < 16; ++r) acc[r] = bt[-(32 * tt + (r & 3) + 8 * (r >> 2))];
            const LAS bf16* kp = Ks + (32 * T + r32) * KPITCH + 8 * h;
#pragma unroll
            for (int k = 0; k < 4; ++k) { const bf16x8 kf = *(const LAS bf16x8*)(kp + 16 * k); acc = __builtin_amdgcn_mfma_f32_32x32x16_bf16(kf, qf[k], acc, 0, 0, 0); }
            s[tt] = acc;
        }
    }
    float m = sink2;
#pragma unroll
    for (int tt = 0; tt < 5; ++tt)
#pragma unroll
        for (int r = 0; r < 16; ++r) m = fmaxf(m, s[tt][r]);
    m = fmaxf(m, __shfl_xor(m, 32));
    float l = 0.f; constexpr float CS = 0.125f * LOG2E; const float mneg = -CS * m;
#pragma unroll
    for (int tt = 0; tt < 5; ++tt)
#pragma unroll
        for (int r = 0; r < 16; ++r) { const float p = __builtin_amdgcn_exp2f(__builtin_fmaf(s[tt][r], CS, mneg)); s[tt][r] = p; l += p; }
    l += __shfl_xor(l, 32); l += __builtin_amdgcn_exp2f(__builtin_fmaf(sink2, CS, mneg));
    f32x16 o[2];
#pragma unroll
    for (int r = 0; r < 16; ++r) { o[0][r] = 0.f; o[1][r] = 0.f; }
    const int q4 = (lane & 15) >> 2, p4 = lane & 3, dblk = (lane >> 4) & 1;
    const LAS char* vb = (const LAS char*)Vs + (4 * h + q4) * 64 + dblk * 32 + p4 * 8;
#pragma unroll
    for (int tt = 0; tt < 5; ++tt) {
        const int T = t0 + tt;
        if (T >= skip_lt) {
#pragma unroll
            for (int ks = 0; ks < 2; ++ks) {
                v4u pw; pw.x = cvtpk(s[tt][8 * ks + 0], s[tt][8 * ks + 1]); pw.y = cvtpk(s[tt][8 * ks + 2], s[tt][8 * ks + 3]);
                pw.z = cvtpk(s[tt][8 * ks + 4], s[tt][8 * ks + 5]); pw.w = cvtpk(s[tt][8 * ks + 6], s[tt][8 * ks + 7]);
                const bf16x8 pb = __builtin_bit_cast(bf16x8, pw);
#pragma unroll
                for (int dt = 0; dt < 2; ++dt) {
                    const v4i16_t lo = lds_tr16(vb + dt * 16384 + (32 * T + 16 * ks) * 64), hi = lds_tr16(vb + dt * 16384 + (32 * T + 16 * ks + 8) * 64);
                    const bf16x8 va = (bf16x8){lo[0], lo[1], lo[2], lo[3], hi[0], hi[1], hi[2], hi[3]};
                    o[dt] = __builtin_amdgcn_mfma_f32_32x32x16_bf16(va, pb, o[dt], 0, 0, 0);
                }
            }
        }
    }
    const float rl = __builtin_amdgcn_rcpf(l);
#pragma unroll
    for (int dt = 0; dt < 2; ++dt)
#pragma unroll
        for (int rq = 0; rq < 4; ++rq) { u32x2_t w; w.x = cvtpk(o[dt][4 * rq + 0] * rl, o[dt][4 * rq + 1] * rl); w.y = cvtpk(o[dt][4 * rq + 2] * rl, o[dt][4 * rq + 3] * rl);
            *(GAS u32x2_t*)(optr + 32 * dt + 8 * rq + 4 * h) = w; }
}
__device__ __forceinline__ void attn_v1(Frame& F, const Args& a, int u0, int ustride) {
    unsigned char* ws = a.ws;
    const bf16* QKV = (const bf16*)(ws + WS_QKV); bf16* ATT = (bf16*)(ws + WS_ATT);
    LAS bf16* Ks = (LAS bf16*)(F.lds); LAS bf16* Vs = (LAS bf16*)(F.lds + 256 * KPITCH * 2); LAS float* biasM = (LAS float*)(F.lds + 256 * KPITCH * 2 + 32768);
    const float* relb = a.in[7]; const float* sinks = a.in[10]; const float* cwk = a.in[2]; const float* cwv = a.in[3];
    const int tid = F.tid, lane = F.lane, wave = F.wave;
#define ATT_LOAD(u_, kr, vr) do { const bool pr_ = (u_) < 512; int b_, qb_, kv_; if (pr_) { b_ = (u_) >> 5; qb_ = ((u_) >> 1) & 15; kv_ = (u_) & 1; } else { b_ = ((u_) - 512) >> 1; qb_ = 0; kv_ = (u_) & 1; } \
        _Pragma("unroll") for (int i_ = 0; i_ < 4; ++i_) { const int c_ = tid + 512 * i_, li_ = c_ >> 3, ch_ = c_ & 7; v4u kvv = (v4u){0u, 0u, 0u, 0u}, vvv = kvv; \
            if (pr_) { const int pos_ = 128 * qb_ - 128 + li_; \
                if (pos_ >= 0) { const bf16* src = QKV + (size_t)(b_ * SEQ + pos_) * QKVW + 512 + kv_ * 64 + ch_ * 8; kvv = *(const GAS v4u*)src; vvv = *(const GAS v4u*)(src + 128); } \
            } else if (li_ < 128) { const float* sk = cwk + ((size_t)(b_ * 128 + li_) * 2 + kv_) * 64 + ch_ * 8; const float* sv = cwv + ((size_t)(b_ * 128 + li_) * 2 + kv_) * 64 + ch_ * 8; \
                const f32x4 k0_ = *(const GAS f32x4*)sk, k1_ = *(const GAS f32x4*)(sk + 4), v0_ = *(const GAS f32x4*)sv, v1_ = *(const GAS f32x4*)(sv + 4); \
                kvv.x = pk2(k0_[0], k0_[1]); kvv.y = pk2(k0_[2], k0_[3]); kvv.z = pk2(k1_[0], k1_[1]); kvv.w = pk2(k1_[2], k1_[3]); \
                vvv.x = pk2(v0_[0], v0_[1]); vvv.y = pk2(v0_[2], v0_[3]); vvv.z = pk2(v1_[0], v1_[1]); vvv.w = pk2(v1_[2], v1_[3]); \
            } else if (li_ < 128 + DECT) { const bf16* src = QKV + (size_t)(MP + b_ * DECT + li_ - 128) * QKVW + 512 + kv_ * 64 + ch_ * 8; kvv = *(const GAS v4u*)src; vvv = *(const GAS v4u*)(src + 128); } \
            kr[i_] = kvv; vr[i_] = vvv; } } while (0)
    v4u kreg[4], vreg[4];
    if (u0 < 768) ATT_LOAD(u0, kreg, vreg);
    for (int u = u0; u < 768; u += ustride) {
        const bool prompt = u < 512;
        int b, qb, kv; if (prompt) { b = u >> 5; qb = (u >> 1) & 15; kv = u & 1; } else { b = (u - 512) >> 1; qb = 0; kv = u & 1; }
        __syncthreads();
#pragma unroll
        for (int i = 0; i < 4; ++i) { const int c = tid + 512 * i, li = c >> 3, ch = c & 7;
            *(LAS v4u*)(Ks + li * KPITCH + ch * 8) = kreg[i]; *(LAS v4u*)(Vs + (ch >> 2) * 8192 + li * 32 + (ch & 3) * 8) = vreg[i]; }
        if (u + ustride < 768) ATT_LOAD(u + ustride, kreg, vreg);
        for (int idx = tid; idx < 768; idx += 512) { const int g = idx / 192, e = idx - g * 192, dist = e - 32;
            biasM[idx] = (dist >= 0 && dist < 128) ? relb[(int)T5_BUCKET[dist] * 8 + kv * 4 + g] * 8.0f : -1e30f; }
        bf16x8 qa[4]; int rowa, rowb, heada; float sinka;
        if (prompt) { const int g = wave >> 1; heada = kv * 4 + g; rowa = b * SEQ + qb * 128 + (wave & 1) * 64 + (lane & 31); rowb = rowa + 32; }
        else { const int i = lane & 7, g = (lane >> 3) & 3; heada = kv * 4 + g; rowa = MP + b * DECT + i; rowb = rowa; }
        sinka = sinks[heada] * 8.0f;
        const bf16* qp = QKV + (size_t)rowa * QKVW + heada * 64 + 8 * (lane >> 5); const bf16* qp2 = QKV + (size_t)rowb * QKVW + heada * 64 + 8 * (lane >> 5);
#pragma unroll
        for (int k = 0; k < 4; ++k) qa[k] = *(const GAS bf16x8*)(qp + 16 * k);
        __syncthreads();
        if (prompt) {
            const int g = wave >> 1, q0 = (wave & 1) * 64;
#pragma unroll 1
            for (int blk = 0; blk < 2; ++blk) {
                attn_block(Ks, Vs, biasM, qa, ATT + (size_t)(rowa + 32 * blk) * RW + heada * 64, (q0 + 32 * blk) >> 5, (qb == 0) ? 4 : 0, lane & 31, g, sinka, lane);
                if (blk == 0) {
#pragma unroll
                    for (int k = 0; k < 4; ++k) qa[k] = *(const GAS bf16x8*)(qp2 + 16 * k); } }
        } else if (wave == 0) {
            attn_block(Ks, Vs, biasM, qa, ATT + (size_t)rowa * RW + heada * 64, 0, 0, lane & 7, (lane >> 3) & 3, sinka, lane);
        }
    }
}
__device__ __forceinline__ void state_copies(Frame& F, const Args& a, int w0, int wstride) {
    unsigned char* ws = a.ws; float* out = a.out;
    const bf16* QKV = (const bf16*)(ws + WS_QKV); const bf16* RWB = (const bf16*)(ws + WS_RWB); const float* cwk = a.in[2]; const float* cwv = a.in[3];
    const size_t gt = (size_t)w0 * 512 + F.tid, GT = (size_t)wstride * 512;
    for (size_t i = gt; i < (size_t)NB * 128 * 32; i += GT) { const int c = (int)(i & 31) * 4, j = (int)((i >> 5) & 127), b = (int)(i >> 12);
        const bf16* src = QKV + (size_t)(b * SEQ + SEQ - 128 + j) * QKVW + 512 + c; const u32x2_t k2 = *(const GAS u32x2_t*)src, v2 = *(const GAS u32x2_t*)(src + 128);
        *(GAS f32x4*)(out + O_PWK + 4 * i) = (f32x4){bflo(k2.x), bfhi(k2.x), bflo(k2.y), bfhi(k2.y)}; *(GAS f32x4*)(out + O_PWV + 4 * i) = (f32x4){bflo(v2.x), bfhi(v2.x), bflo(v2.y), bfhi(v2.y)}; }
    for (size_t i = gt; i < (size_t)DECB * 128 * 32; i += GT) { const int c = (int)(i & 31) * 4, j = (int)((i >> 5) & 127), b = (int)(i >> 12);
        if (j < 128 - DECT) { *(GAS f32x4*)(out + O_SWK + 4 * i) = *(const GAS f32x4*)(cwk + (size_t)(b * 128 + j + DECT) * 128 + c); *(GAS f32x4*)(out + O_SWV + 4 * i) = *(const GAS f32x4*)(cwv + (size_t)(b * 128 + j + DECT) * 128 + c); }
        else { const bf16* src = QKV + (size_t)(MP + b * DECT + j - (128 - DECT)) * QKVW + 512 + c; const u32x2_t k2 = *(const GAS u32x2_t*)src, v2 = *(const GAS u32x2_t*)(src + 128);
            *(GAS f32x4*)(out + O_SWK + 4 * i) = (f32x4){bflo(k2.x), bfhi(k2.x), bflo(k2.y), bfhi(k2.y)}; *(GAS f32x4*)(out + O_SWV + 4 * i) = (f32x4){bflo(v2.x), bfhi(v2.x), bflo(v2.y), bfhi(v2.y)}; } }
    for (size_t i = gt; i < (size_t)NB * (RWS / 4); i += GT) { const int c = (int)(i % (RWS / 4)) * 4, b = (int)(i / (RWS / 4)); const u32x2_t r2 = *(const GAS u32x2_t*)(RWB + (size_t)(b * SEQ + SEQ - 1) * RWS + c);
        *(GAS f32x4*)(out + O_PSH + 4 * i) = (f32x4){bflo(r2.x), bfhi(r2.x), bflo(r2.y), bfhi(r2.y)}; }
    for (size_t i = gt; i < (size_t)DECB * (RWS / 4); i += GT) { const int c = (int)(i % (RWS / 4)) * 4, b = (int)(i / (RWS / 4)); const u32x2_t r2 = *(const GAS u32x2_t*)(RWB + (size_t)(MP + b * DECT + DECT - 1) * RWS + c);
        *(GAS f32x4*)(out + O_SSH + 4 * i) = (f32x4){bflo(r2.x), bfhi(r2.x), bflo(r2.y), bfhi(r2.y)}; }
}

__device__ __forceinline__ void rwkv_scan_sample(Frame& F, const Args& a, int b) {
    unsigned char* ws = a.ws;
    const bf16* RWB = (const bf16*)(ws + WS_RWB); const float* DEC = a.out; const bf16* ASIG = (const bf16*)(ws + WS_ASIG); bf16* GO = (bf16*)(ws + WS_RWO);
    const float* sshift = a.in[4]; const float* swkv = a.in[5]; const float* mu = a.in[11]; const float* k_k = a.in[17]; const float* k_a = a.in[18]; const float* r_k = a.in[19];
    const float* lnx_g = a.in[20]; const float* lnx_b = a.in[21];
    const int h = F.wave, lane = F.lane, cch = h * 64 + lane, row0 = MP + b * DECT;
    LAS float* V6 = (LAS float*)F.lds + h * (DECT * 6 * 64 + 64);
    LAS float* BONw = V6 + DECT * 6 * 64;
#pragma unroll
    for (int t = 0; t < DECT; ++t) { const int row = row0 + t; const bf16* pr = RWB + (size_t)row * RWS;
        const float p_r = bf2f(pr[cch]), p_k = bf2f(pr[RW + cch]), p_v = bf2f(pr[2 * RW + cch]);
        float q_r, q_k, q_v;
        if (t == 0) { const float* sp = sshift + (size_t)b * RWS; q_r = sp[cch]; q_k = sp[RW + cch]; q_v = sp[2 * RW + cch]; }
        else { q_r = bf2f(pr[cch - RWS]); q_k = bf2f(pr[RW + cch - RWS]); q_v = bf2f(pr[2 * RW + cch - RWS]); }
        const float r = p_r + mu[cch] * (q_r - p_r), kx = p_k + mu[RW + cch] * (q_k - p_k), v = p_v + mu[2 * RW + cch] * (q_v - p_v);
        const size_t o = (size_t)row * RW + cch; const float w = __expf(DEC[o]); const float as = bf2f(ASIG[o]);
        const float kkr = kx * k_k[cch]; const float ss = wave_sum(kkr * kkr); const float kk = kkr * __builtin_amdgcn_rsqf(fmaxf(ss, 1e-24f));
        const float kp = kx * (1.0f + (as - 1.0f) * k_a[cch]); const float bon = wave_sum(r * kp * r_k[cch]);
        LAS float* vt = V6 + t * 384; vt[lane] = r; vt[64 + lane] = w; vt[128 + lane] = kp; vt[192 + lane] = -kk; vt[256 + lane] = kk * as; vt[320 + lane] = v;
        if (lane == 0) BONw[t] = bon; }
    float S[64];
    { const GAS f32x4* sp = (const GAS f32x4*)(swkv + ((size_t)(b * 8 + h) * 64 + lane) * 64);
#pragma unroll
      for (int q = 0; q < 16; ++q) { const f32x4 x = sp[q]; S[4 * q] = x[0]; S[4 * q + 1] = x[1]; S[4 * q + 2] = x[2]; S[4 * q + 3] = x[3]; } }
    asm volatile("s_waitcnt lgkmcnt(0)" ::: "memory");
#pragma unroll 1
    for (int t = 0; t < DECT; ++t) { const LAS float* vt = V6 + t * 384; const float vi = vt[320 + lane];
        float sa = 0.f;
#pragma unroll
        for (int q = 0; q < 16; ++q) { const f32x4 a4 = *(const LAS f32x4*)(vt + 192 + 4 * q); sa += S[4 * q] * a4[0] + S[4 * q + 1] * a4[1] + S[4 * q + 2] * a4[2] + S[4 * q + 3] * a4[3]; }
        float y = 0.f;
#pragma unroll
        for (int q = 0; q < 16; ++q) { const f32x4 w4 = *(const LAS f32x4*)(vt + 64 + 4 * q), b4 = *(const LAS f32x4*)(vt + 256 + 4 * q), k4 = *(const LAS f32x4*)(vt + 128 + 4 * q), r4 = *(const LAS f32x4*)(vt + 4 * q);
#pragma unroll
            for (int e = 0; e < 4; ++e) { const float sn = S[4 * q + e] * w4[e] + sa * b4[e] + vi * k4[e]; S[4 * q + e] = sn; y += sn * r4[e]; } }
        const float mean = wave_sum(y) * (1.0f / 64.0f); const float d = y - mean; const float var = wave_sum(d * d) * (1.0f / 64.0f);
        float yn = d * __builtin_amdgcn_rsqf(var + 64e-5f); yn = yn * lnx_g[cch] + lnx_b[cch] + BONw[t] * vi;
        const size_t o = (size_t)(row0 + t) * RW + cch; GO[o] = (bf16)f2bf(yn * bf2f(GO[o])); }
    { GAS f32x4* so = (GAS f32x4*)(a.out + O_SWKV + ((size_t)(b * 8 + h) * 64 + lane) * 64);
#pragma unroll
      for (int q = 0; q < 16; ++q) so[q] = (f32x4){S[4 * q], S[4 * q + 1], S[4 * q + 2], S[4 * q + 3]}; }
}

constexpr int KP = 72;
constexpr int L_AT = 0, L_RT = 9216, L_BT = 18432, L_KT = 27648, L_AAK = 36864, L_ARB = 46080, L_ARK = 55296, L_AAB = 64512, L_TM = 73728, L_S0B = 82944  ,
              L_BH = 101376, L_KH = 109568, L_VN = 117760, L_CL = 125952, L_LC = 143360, L_BON = 143616, L_SEG = 143872, L_ST = 145920, L_GB = 146944, L_RW_END = 156160;
constexpr int L_CT = 156160;
constexpr int CLP = 68;
constexpr int L_TL = L_AAK, L_LA = L_ARB, L_SG0 = L_ARK, L_SG1 = L_AAB, L_ASG = L_BT;
constexpr int L_XG = 146944  , L_SA = L_KT;
__device__ __forceinline__ void unpack8(const v4u w, float (&o)[8]) { o[0] = bflo(w.x); o[1] = bfhi(w.x); o[2] = bflo(w.y); o[3] = bfhi(w.y); o[4] = bflo(w.z); o[5] = bfhi(w.z); o[6] = bflo(w.w); o[7] = bfhi(w.w); }
__device__ __forceinline__ v4u packf8(const float (&v)[8]) { v4u w; w.x = cvtpk(v[0], v[1]); w.y = cvtpk(v[2], v[3]); w.z = cvtpk(v[4], v[5]); w.w = cvtpk(v[6], v[7]); return w; }
__device__ __forceinline__ bf16x8 trfrag(const LAS bf16* p, int second_off) {
    const v4i16_t lo = lds_tr16(p), hi = lds_tr16(p + second_off); return (bf16x8){lo[0], lo[1], lo[2], lo[3], hi[0], hi[1], hi[2], hi[3]}; }
__device__ __forceinline__ bf16x8 acc8_to_bf(const f32x16& x, int s) {
    v4u w; w.x = cvtpk(x[8 * s + 0], x[8 * s + 1]); w.y = cvtpk(x[8 * s + 2], x[8 * s + 3]); w.z = cvtpk(x[8 * s + 4], x[8 * s + 5]); w.w = cvtpk(x[8 * s + 6], x[8 * s + 7]);
    return __builtin_bit_cast(bf16x8, w); }
__device__ __forceinline__ f32x16 zero16() { f32x16 z;
#pragma unroll
    for (int r = 0; r < 16; ++r) z[r] = 0.f;
    return z; }
#define MFMA32(A, B, C) __builtin_amdgcn_mfma_f32_32x32x16_bf16((A), (B), (C), 0, 0, 0)
__device__ __forceinline__ void store_tile_nm(LAS bf16* dst, const f32x16& acc, int nrow, int m0, int hh) {
#pragma unroll
    for (int rq = 0; rq < 4; ++rq) { u32x2_t w; w.x = cvtpk(acc[4 * rq + 0], acc[4 * rq + 1]); w.y = cvtpk(acc[4 * rq + 2], acc[4 * rq + 3]);
        *(LAS u32x2_t*)(dst + nrow * KP + m0 + 8 * rq + 4 * hh) = w; }
}
__device__ __forceinline__ void rwkv_prep_mfma(Frame& F, const Args& a, int ustart, int ustride, int uend) {
    unsigned char* ws = a.ws;
    const bf16* RWB = (const bf16*)(ws + WS_RWB); float* DEC = a.out; bf16* ASIG = (bf16*)(ws + WS_ASIG); bf16* GO = (bf16*)(ws + WS_RWO);
    const bf16* W2T = (const bf16*)(ws + WS_W2T); const bf16* A2T = (const bf16*)(ws + WS_A2T); const bf16* G2T = (const bf16*)(ws + WS_G2T);
    const float* sshift = a.in[4]; const float* mu = a.in[11]; const float* w0 = a.in[12]; const float* a0 = a.in[14];
    LAS bf16* TL = (LAS bf16*)F.lds; LAS bf16* LA = TL + 32 * KP; LAS bf16* SG0 = LA + 32 * KP; LAS bf16* SG1 = SG0 + 32 * KP;
    const int tid = F.tid, lane = F.lane, wave = F.wave, r32 = lane & 31, hh = lane >> 5;
    const int tok = tid >> 4, part = tid & 15, c0 = 3 * RW + 16 * part;
    const float kx = (part < 4) ? -2.0f * LOG2E : -LOG2E, sA = (part < 4) ? 2.0f : (part < 8) ? 0.0f : 1.0f, sB = (part >= 4 && part < 8) ? 1.0f : 0.0f, sC = (part < 4) ? -1.0f : 0.0f;
    LAS bf16* dstb = (part < 4) ? TL : (part < 8) ? LA : (part < 12) ? SG0 : SG1; const int dcol = 16 * (part & 3);
#define PREP_ROWS(u_, cur0, cur1, prv0, prv1) do { const int row_ = (u_) * 32 + tok; const bf16* pr_ = RWB + (size_t)row_ * RWS + c0; cur0 = *(const GAS v4u*)pr_; cur1 = *(const GAS v4u*)(pr_ + 8); \
        const bool hp_ = (row_ < MP) ? ((row_ & (SEQ - 1)) != 0) : (((row_ - MP) & (DECT - 1)) != 0); const bf16* pq_ = hp_ ? pr_ - RWS : pr_; prv0 = *(const GAS v4u*)pq_; prv1 = *(const GAS v4u*)(pq_ + 8); } while (0)
    const int h = wave;
    v4u nc0, nc1, np0, np1;
    if (ustart < uend) PREP_ROWS(ustart, nc0, nc1, np0, np1);
    float mu16[16];
#pragma unroll
    for (int e = 0; e < 16; ++e) mu16[e] = mu[c0 + e];
    for (int u = ustart; u < uend; u += ustride) {
        __syncthreads();
        bf16x8 bwn[8];
#pragma unroll
        for (int ks = 0; ks < 8; ++ks) bwn[ks] = *(const GAS bf16x8*)(W2T + (size_t)(h * 64 + r32) * 64 + 16 * (ks & 3) + 8 * hh);
        { const int row = u * 32 + tok; const v4u cv[2] = {nc0, nc1}; const v4u pv[2] = {np0, np1};
          const bool hp = (row < MP) ? ((row & (SEQ - 1)) != 0) : (((row - MP) & (DECT - 1)) != 0);
#pragma unroll
          for (int q = 0; q < 2; ++q) { float pc[8], pp[8], o8[8]; unpack8(cv[q], pc); unpack8(pv[q], pp);
              if (!hp) {
                  if (row < MP) {
#pragma unroll
                      for (int e = 0; e < 8; ++e) pp[e] = 0.f;
                  } else {
#pragma unroll
                      for (int e = 0; e < 8; ++e) pp[e] = sshift[(size_t)((row - MP) >> 3) * RWS + c0 + 8 * q + e]; } }
#pragma unroll
              for (int e = 0; e < 8; ++e) { const float xs = pc[e] + mu16[8 * q + e] * (pp[e] - pc[e]); o8[e] = sA * __builtin_amdgcn_rcpf(1.0f + __builtin_amdgcn_exp2f(kx * xs)) + (sB * xs + sC); }
              *(LAS v4u*)(dstb + tok * KP + dcol + 8 * q) = packf8(o8); } }
        if (u + ustride < uend) PREP_ROWS(u + ustride, nc0, nc1, np0, np1);
        __syncthreads();
#pragma unroll 1
        for (int step = 0; step < 6; ++step) { const int prod = step >> 1, jt = step & 1, ch = h * 64 + 32 * jt + r32;
            bf16x8 bw[8];
#pragma unroll
            for (int ks = 0; ks < 8; ++ks) bw[ks] = bwn[ks];
            if (step < 5) { const int pn_ = (step + 1) >> 1, jn_ = (step + 1) & 1, chn = h * 64 + 32 * jn_ + r32;
                const bf16* WT = (pn_ == 0) ? W2T : (pn_ == 1) ? A2T : G2T; const int ldw = (pn_ == 2) ? 128 : 64, kmask = (pn_ == 2) ? 7 : 3;
#pragma unroll
                for (int ks = 0; ks < 8; ++ks) bwn[ks] = *(const GAS bf16x8*)(WT + (size_t)chn * ldw + 16 * (ks & kmask) + 8 * hh); }
            const float bias = (prod == 0) ? w0[ch] : (prod == 1) ? a0[ch] : 0.f;
            f32x16 acc = zero16();
            const LAS bf16* As0 = (prod == 0) ? TL : (prod == 1) ? LA : SG0;
#pragma unroll
            for (int ks = 0; ks < 4; ++ks) acc = MFMA32(*(const LAS bf16x8*)(As0 + r32 * KP + 16 * ks + 8 * hh), bw[ks], acc);
            if (prod == 2) {
#pragma unroll
                for (int ks = 0; ks < 4; ++ks) acc = MFMA32(*(const LAS bf16x8*)(SG1 + r32 * KP + 16 * ks + 8 * hh), bw[4 + ks], acc); }
            LAS float* scf = (LAS float*)(F.lds + 4 * 32 * KP * 2 + wave * 4096); LAS bf16* sch = (LAS bf16*)scf;
            const size_t ob = (size_t)(u * 32) * RW + h * 64 + 32 * jt;
            if (prod == 0) {
#pragma unroll
                for (int r = 0; r < 16; ++r) { const float sg = __builtin_amdgcn_rcpf(1.0f + __builtin_amdgcn_exp2f(-LOG2E * (acc[r] + bias))); scf[((r & 3) + 8 * (r >> 2) + 4 * hh) * 32 + r32] = -0.6065306597126334f * sg; }
#pragma unroll
                for (int q = 0; q < 4; ++q) { const int idx = q * 64 + lane, rw_ = idx >> 3, c4 = idx & 7; *(GAS f32x4*)(DEC + ob + (size_t)rw_ * RW + 4 * c4) = *(const LAS f32x4*)(scf + rw_ * 32 + 4 * c4); }
            } else {
#pragma unroll
                for (int r = 0; r < 16; ++r) { const float x = acc[r] + bias; const float y = (prod == 1) ? __builtin_amdgcn_rcpf(1.0f + __builtin_amdgcn_exp2f(-LOG2E * x)) : x; sch[((r & 3) + 8 * (r >> 2) + 4 * hh) * 32 + r32] = (bf16)f2bf(y); }
                bf16* dst = (prod == 1) ? ASIG : GO;
#pragma unroll
                for (int q = 0; q < 2; ++q) { const int idx = q * 64 + lane, rw_ = idx >> 2, c8 = idx & 3; *(GAS v4u*)(dst + ob + (size_t)rw_ * RW + 8 * c8) = *(const LAS v4u*)(sch + rw_ * 32 + 8 * c8); } }
            asm volatile("s_waitcnt lgkmcnt(0)" ::: "memory"); }
    }
#undef PREP_ROWS
}

__device__ __forceinline__ void mtile(const LAS bf16* Asrc, const LAS bf16* Bsrc, int sm, int tn, LAS bf16* dst, int lim, LAS float* diag, int r32, int hh) {
    f32x16 acc = zero16();
#pragma unroll
    for (int ks = 0; ks < 4; ++ks) acc = MFMA32(*(const LAS bf16x8*)(Asrc + (32 * sm + r32) * KP + 16 * ks + 8 * hh), *(const LAS bf16x8*)(Bsrc + (32 * tn + r32) * KP + 16 * ks + 8 * hh), acc);
    const int t = 32 * tn + r32;
#pragma unroll
    for (int rq = 0; rq < 4; ++rq) { const int s0 = 32 * sm + 8 * rq + 4 * hh; float v4[4];
#pragma unroll
        for (int e = 0; e < 4; ++e) v4[e] = (s0 + e < t + lim) ? acc[4 * rq + e] : 0.f;
        u32x2_t w; w.x = cvtpk(v4[0], v4[1]); w.y = cvtpk(v4[2], v4[3]); *(LAS u32x2_t*)(dst + t * KP + s0) = w;
        if (diag != nullptr && tn == sm) *(LAS f32x4*)(diag + t * 36 + 8 * rq + 4 * hh) = (f32x4){v4[0], v4[1], v4[2], v4[3]}; }
}
template <bool DRY, int SKIP = 0> __device__ __forceinline__ void rwkv_chunked(Frame& F, const Args& a, int b, int h) {
    unsigned char* ws = a.ws;
    const bf16* RWB = (const bf16*)(ws + WS_RWB); bf16* GO = (bf16*)(ws + WS_RWO); const float* DEC = a.out; const bf16* ASIG = (const bf16*)(ws + WS_ASIG);
    const float* w0p = a.in[12]; const float* a0p = a.in[14];
    const float* mu = a.in[11]; const float* k_k = a.in[17]; const float* k_a = a.in[18]; const float* r_k = a.in[19]; const float* lnx_g = a.in[20]; const float* lnx_b = a.in[21];
    LAS unsigned char* L = F.lds;
    LAS bf16* At = (LAS bf16*)(L + L_AT); LAS bf16* Rt = (LAS bf16*)(L + L_RT); LAS bf16* Bt = (LAS bf16*)(L + L_BT); LAS bf16* Kt = (LAS bf16*)(L + L_KT);
    LAS bf16* Aak = (LAS bf16*)(L + L_AAK); LAS bf16* Arb = (LAS bf16*)(L + L_ARB); LAS bf16* Ark = (LAS bf16*)(L + L_ARK); LAS bf16* Aab = (LAS bf16*)(L + L_AAB);
    LAS bf16* Tm = (LAS bf16*)(L + L_TM); LAS bf16* XGt = (LAS bf16*)(L + L_XG); LAS bf16* SAt = (LAS bf16*)(L + L_SA);
    LAS bf16* Bh = (LAS bf16*)(L + L_BH); LAS bf16* Kh = (LAS bf16*)(L + L_KH); LAS bf16* Vn = (LAS bf16*)(L + L_VN);
    LAS bf16* TL = (LAS bf16*)(L + L_TL); LAS bf16* LA = (LAS bf16*)(L + L_LA); LAS bf16* SG0 = (LAS bf16*)(L + L_SG0); LAS bf16* SG1 = (LAS bf16*)(L + L_SG1); LAS bf16* ASg = (LAS bf16*)(L + L_ASG); LAS bf16* Gb = (LAS bf16*)(L + L_GB);
    LAS float* CL = (LAS float*)(L + L_CL); LAS float* Lc = (LAS float*)(L + L_LC); LAS float* BON = (LAS float*)(L + L_BON); LAS float* SEG = (LAS float*)(L + L_SEG); LAS float* ST = (LAS float*)(L + L_ST);
    const int tid0 = F.tid, wave = F.wave;
    __syncthreads();
    for (int i = tid0; i < (9216 * 3) / 16; i += 512) ((LAS v4u*)(L + L_TM))[i] = (v4u){0u, 0u, 0u, 0u};
    LAS float* CT = (LAS float*)(L + L_CT);
    for (int i = tid0; i < 896; i += 512) { float v; const int hc = h * 64;
        if (i < 64) v = mu[hc + i]; else if (i < 128) v = mu[RW + hc + i - 64]; else if (i < 192) v = mu[2 * RW + hc + i - 128]; else if (i < 256) v = k_k[hc + i - 192]; else if (i < 320) v = k_a[hc + i - 256];
        else if (i < 384) v = r_k[hc + i - 320]; else if (i < 640) v = mu[3 * RW + i - 384]; else if (i < 704) v = w0p[hc + i - 640]; else if (i < 768) v = a0p[hc + i - 704]; else if (i < 832) v = lnx_g[hc + i - 768]; else v = lnx_b[hc + i - 832];
        CT[i] = v; }
    f32x16 sacc = zero16();
    const int row0 = b * SEQ;
    v4u pf[6], pd[3];
    { const int tk = tid0 >> 3, jq0 = tid0 & 7; const bf16* pr = RWB + (size_t)(row0 + tk) * RWS + h * 64 + 8 * jq0; const bf16* pq = (tk != 0) ? pr - RWS : pr;
      pf[0] = *(const GAS v4u*)pr; pf[1] = *(const GAS v4u*)(pr + RW); pf[2] = *(const GAS v4u*)(pr + 2 * RW); pf[3] = *(const GAS v4u*)pq; pf[4] = *(const GAS v4u*)(pq + RW); pf[5] = *(const GAS v4u*)(pq + 2 * RW);
      const size_t o = (size_t)(row0 + tk) * RW + h * 64 + 8 * jq0; pd[0] = *(const GAS v4u*)(DEC + o); pd[1] = *(const GAS v4u*)(DEC + o + 4); pd[2] = *(const GAS v4u*)(ASIG + o); }
#define BARL() do { asm volatile("s_waitcnt lgkmcnt(0)" ::: "memory"); __builtin_amdgcn_s_barrier(); asm volatile("" ::: "memory"); } while (0)
    __syncthreads();
#pragma unroll 1
    for (int c = 0; c < SEQ / 64; ++c) {
        int tid = tid0; asm volatile("" : "+v"(tid));
        const int lane = tid & 63, r32 = lane & 31, hh = lane >> 5, q4 = (lane & 15) >> 2, p4 = lane & 3, dblk = (lane >> 4) & 1;
        const int troff = (8 * hh + q4) * 32 + 16 * dblk + 4 * p4;
        const int tok = tid >> 3, jq = tid & 7, cj = h * 64 + 8 * jq;
        const int cur = c & 1;
        LAS bf16* S0cur = (LAS bf16*)(L + L_S0B + cur * 9216); LAS bf16* S0nxt = (LAS bf16*)(L + L_S0B + (cur ^ 1) * 9216);
        BARL();
        const int rowt = row0 + c * 64 + tok; const bool has_prev = (rowt & (SEQ - 1)) != 0;
        const v4u ld_r = pf[0], ld_k = pf[1], ld_v = pf[2], ld_qr = pf[3], ld_qk = pf[4], ld_qv = pf[5];
        const v4u ld_d0 = pd[0], ld_d1 = pd[1], ld_as = pd[2];
        float rr[8], kq[8], vv[8], aa[8], bb[8], lwv[8];
        { float p_r[8], p_k[8], p_v[8], q_r[8], q_k[8], q_v[8];
          unpack8(ld_r, p_r); unpack8(ld_k, p_k); unpack8(ld_v, p_v); unpack8(ld_qr, q_r); unpack8(ld_qk, q_k); unpack8(ld_qv, q_v);
          if (!has_prev) {
#pragma unroll
              for (int e = 0; e < 8; ++e) { q_r[e] = 0.f; q_k[e] = 0.f; q_v[e] = 0.f; } }
          float asg[8]; unpack8(ld_as, asg);
          { const f32x4 d0 = __builtin_bit_cast(f32x4, ld_d0), d1 = __builtin_bit_cast(f32x4, ld_d1);
#pragma unroll
            for (int e = 0; e < 4; ++e) { lwv[e] = d0[e]; lwv[4 + e] = d1[e]; }
            *(LAS f32x4*)(CL + tok * CLP + 8 * jq) = d0; *(LAS f32x4*)(CL + tok * CLP + 8 * jq + 4) = d1; }
          float ss = 0.f, bon = 0.f; float kkr[8];
#pragma unroll
          for (int e = 0; e < 8; ++e) { const float mr = CT[8 * jq + e], mk = CT[64 + 8 * jq + e], mv = CT[128 + 8 * jq + e];
              rr[e] = p_r[e] + mr * (q_r[e] - p_r[e]); const float kx = p_k[e] + mk * (q_k[e] - p_k[e]); vv[e] = p_v[e] + mv * (q_v[e] - p_v[e]);
              kkr[e] = kx * CT[192 + 8 * jq + e]; ss += kkr[e] * kkr[e]; kq[e] = kx * (1.0f + (asg[e] - 1.0f) * CT[256 + 8 * jq + e]); bon += rr[e] * kq[e] * CT[320 + 8 * jq + e]; }
          ss += pg8::dpp_z<0xB1>(ss); ss += pg8::dpp_z<0x4E>(ss); ss += pg8::dpp_z<0x141>(ss);
          bon += pg8::dpp_z<0xB1>(bon); bon += pg8::dpp_z<0x4E>(bon); bon += pg8::dpp_z<0x141>(bon);
          const float rn = __builtin_amdgcn_rsqf(fmaxf(ss, 1e-24f));
#pragma unroll
          for (int e = 0; e < 8; ++e) { const float kk = kkr[e] * rn; aa[e] = -kk; bb[e] = kk * asg[e]; }
          if (jq == 0) BON[tok] = bon; }
        { const int cn = (c + 1 < SEQ / 64) ? c + 1 : c; const bf16* pr = RWB + (size_t)(row0 + cn * 64 + tok) * RWS + cj; const bf16* pq = pr - RWS;
          pf[0] = *(const GAS v4u*)pr; pf[1] = *(const GAS v4u*)(pr + RW); pf[2] = *(const GAS v4u*)(pr + 2 * RW); pf[3] = *(const GAS v4u*)pq; pf[4] = *(const GAS v4u*)(pq + RW); pf[5] = *(const GAS v4u*)(pq + 2 * RW);
          const size_t o = (size_t)(row0 + cn * 64 + tok) * RW + cj; pd[0] = *(const GAS v4u*)(DEC + o); pd[1] = *(const GAS v4u*)(DEC + o + 4); pd[2] = *(const GAS v4u*)(ASIG + o); }
        BARL();
        { const int j = tid & 63, seg = tid >> 6; float c8[8]; float run = 0.f;
#pragma unroll
          for (int e = 0; e < 8; ++e) { run += CL[(8 * seg + e) * CLP + j]; c8[e] = run; }
          SEG[seg * 64 + j] = run;
          BARL();
          float pre = 0.f, tot = 0.f;
#pragma unroll
          for (int s2 = 0; s2 < 8; ++s2) { const float x = SEG[s2 * 64 + j]; tot += x; pre += (s2 < seg) ? x : 0.f; }
#pragma unroll
          for (int e = 0; e < 8; ++e) CL[(8 * seg + e) * CLP + j] = c8[e] + pre;
          if (seg == 0) Lc[j] = __builtin_amdgcn_exp2f(tot * LOG2E); }
        BARL();
        if (!(SKIP & 8)) {
          const f32x4 c0 = *(const LAS f32x4*)(CL + tok * CLP + 8 * jq), c1 = *(const LAS f32x4*)(CL + tok * CLP + 8 * jq + 4);
          const f32x4 t0 = *(const LAS f32x4*)(Lc + 8 * jq), t1 = *(const LAS f32x4*)(Lc + 8 * jq + 4);
          float oat[8], ort[8], obt[8], okt[8], obh[8], okh[8];
#pragma unroll
          for (int e = 0; e < 8; ++e) { const float cl = (e < 4 ? c0[e] : c1[e - 4]), et = (e < 4 ? t0[e] : t1[e - 4]);
              const float e1 = __builtin_amdgcn_exp2f(cl * LOG2E), e2 = __builtin_amdgcn_rcpf(e1), e4 = __builtin_amdgcn_exp2f((cl - lwv[e]) * LOG2E);
              oat[e] = aa[e] * e4; ort[e] = rr[e] * e1; obt[e] = bb[e] * e2; okt[e] = kq[e] * e2; obh[e] = obt[e] * et; okh[e] = okt[e] * et; }
          const int kc = tok * KP + 8 * jq, km = (jq >> 2) * 2048 + tok * 32 + 8 * (jq & 3);
          *(LAS v4u*)(At + kc) = packf8(oat); *(LAS v4u*)(Rt + kc) = packf8(ort); *(LAS v4u*)(Bt + kc) = packf8(obt); *(LAS v4u*)(Kt + kc) = packf8(okt);
          *(LAS v4u*)(Bh + km) = packf8(obh); *(LAS v4u*)(Kh + km) = packf8(okh); *(LAS v4u*)(Vn + km) = packf8(vv); }
        BARL();
        { const int sm = (wave >> 1) & 1, tn = wave & 1; if (wave < 4) mtile(Bt, At, sm, tn, Aab, 0, CL, r32, hh); else mtile(Kt, At, sm, tn, Aak, 0, nullptr, r32, hh); }
        BARL();
        f32x16 xg = zero16();
        if (wave == 0 && !(SKIP & 1)) {
            { const int kb = lane >> 4, cc = lane & 15; float Tr[16]; const LAS float* Ab = CL + (16 * kb) * 36 + 16 * (kb & 1);
              Tr[0] = (cc == 0) ? 1.f : 0.f;
              f32x4 R[16][4];
#pragma unroll
              for (int t = 1; t <= 6; ++t)
#pragma unroll
                  for (int q = 0; q < (t + 3) / 4; ++q) R[t][q] = *(const LAS f32x4*)(Ab + t * 36 + 4 * q);
#pragma unroll
              for (int t = 1; t < 16; ++t) {
                  if (t + 6 < 16) {
#pragma unroll
                      for (int q = 0; q < (t + 6 + 3) / 4; ++q) R[t + 6][q] = *(const LAS f32x4*)(Ab + (t + 6) * 36 + 4 * q); }
                  __builtin_amdgcn_sched_barrier(0);
                  float acc = (t == cc) ? 1.f : 0.f;
#pragma unroll
                  for (int s = 0; s < t; ++s) acc += R[t][s >> 2][s & 3] * Tr[s];
                  Tr[t] = acc; }
#pragma unroll
              for (int t = 0; t < 16; ++t) Tm[(16 * kb + t) * KP + 16 * kb + cc] = (bf16)f2bf(Tr[t]); }
            asm volatile("s_waitcnt lgkmcnt(0)" ::: "memory");
            {
              const int arow = (r32 < 16) ? 16 + r32 : 32 + r32, acol = ((r32 < 16) ? 0 : 32) + 8 * hh;
              const bf16x8 af = *(const LAS bf16x8*)(Aab + arow * KP + acol);
              const int rb = 32 * dblk; const LAS bf16* tp = Tm + (rb + 8 * hh + q4) * KP + rb + 4 * p4;
              const f32x16 W1 = MFMA32(af, trfrag(tp, 4 * KP), zero16());
              f32x16 E = zero16();
#pragma unroll
              for (int s = 0; s < 2; ++s) { const bool on = (s == 0) ? (r32 < 16) : (r32 >= 16); const int base = (s == 0) ? (16 + r32) * KP + 16 + 4 * hh : (32 + r32) * KP + 48 + 4 * hh;
                  u32x2_t lo = *(const LAS u32x2_t*)(Tm + base), hi = *(const LAS u32x2_t*)(Tm + base + 8);
                  if (!on) { lo = (u32x2_t){0u, 0u}; hi = lo; }
                  const v4u aw = (v4u){lo.x, lo.y, hi.x, hi.y};
                  E = MFMA32(__builtin_bit_cast(bf16x8, aw), acc8_to_bf(W1, s), E); }
#pragma unroll
              for (int reg = 0; reg < 16; ++reg) { const int rw = (reg & 3) + 8 * (reg >> 2) + 4 * hh;
                  if (r32 < 16 && reg < 8) Tm[(16 + rw) * KP + r32] = (bf16)f2bf(E[reg]);
                  if (r32 >= 16 && reg >= 8) Tm[(32 + rw) * KP + 16 + r32] = (bf16)f2bf(E[reg]); } }
            asm volatile("s_waitcnt lgkmcnt(0)" ::: "memory");
            {
              f32x16 W2 = zero16();
#pragma unroll
              for (int ks = 0; ks < 2; ++ks) { const bf16x8 af = *(const LAS bf16x8*)(Aab + (32 + r32) * KP + 16 * ks + 8 * hh);
                  const LAS bf16* tp = Tm + (16 * ks + 8 * hh + q4) * KP + 16 * dblk + 4 * p4; W2 = MFMA32(af, trfrag(tp, 4 * KP), W2); }
              f32x16 Fm = zero16();
#pragma unroll
              for (int s = 0; s < 2; ++s) { const int base = (32 + r32) * KP + 32 + 16 * s + 4 * hh; const u32x2_t lo = *(const LAS u32x2_t*)(Tm + base), hi = *(const LAS u32x2_t*)(Tm + base + 8);
                  const v4u aw = (v4u){lo.x, lo.y, hi.x, hi.y}; Fm = MFMA32(__builtin_bit_cast(bf16x8, aw), acc8_to_bf(W2, s), Fm); }
#pragma unroll
              for (int reg = 0; reg < 16; ++reg) { const int rw = (reg & 3) + 8 * (reg >> 2) + 4 * hh; Tm[(32 + rw) * KP + r32] = (bf16)f2bf(Fm[reg]); } }
        } else if (wave < 4) {
#pragma unroll 1
            for (int idx = 3 * (wave - 1); idx < 3 * wave && idx < 8; ++idx) mtile((idx < 4) ? Bt : Kt, Rt, (idx >> 1) & 1, idx & 1, (idx < 4) ? Arb : Ark, 1, nullptr, r32, hh);
        } else {
            const int tm = (wave >> 1) & 1, inn = wave & 1;
#pragma unroll
            for (int ks = 0; ks < 4; ++ks) { const bf16x8 af = *(const LAS bf16x8*)(Aak + (32 * tm + r32) * KP + 16 * ks + 8 * hh); xg = MFMA32(af, trfrag(Vn + inn * 2048 + 16 * ks * 32 + troff, 128), xg); }
#pragma unroll
            for (int ks = 0; ks < 4; ++ks) { const bf16x8 af = *(const LAS bf16x8*)(At + (32 * tm + r32) * KP + 16 * ks + 8 * hh); const bf16x8 bf = *(const LAS bf16x8*)(S0cur + (32 * inn + r32) * KP + 16 * ks + 8 * hh); xg = MFMA32(af, bf, xg); }
            store_tile_nm(XGt, xg, 32 * inn + r32, 32 * tm, hh);
        }
        BARL();
        f32x16 yv = zero16(); float mean = 0.f, rstd = 0.f; u32x2_t gq[4] = {};
        if (wave < 4) { const int tm = (wave >> 1) & 1, inn = wave & 1; f32x16 sa = zero16();
#pragma unroll
            for (int ks = 0; ks < 4; ++ks) { const bf16x8 af = *(const LAS bf16x8*)(Tm + (32 * tm + r32) * KP + 16 * ks + 8 * hh); const bf16x8 bf = *(const LAS bf16x8*)(XGt + (32 * inn + r32) * KP + 16 * ks + 8 * hh); sa = MFMA32(af, bf, sa); }
            store_tile_nm(SAt, sa, 32 * inn + r32, 32 * tm, hh);
        } else if (!(SKIP & 16)) { const int im = (wave >> 1) & 1, tn = wave & 1;
            { const size_t rowo = (size_t)(row0 + c * 64 + 32 * tn + r32) * RW + h * 64 + 32 * im + 4 * hh;
#pragma unroll
              for (int rq = 0; rq < 4; ++rq) gq[rq] = *(const GAS u32x2_t*)(GO + rowo + 8 * rq); }
#pragma unroll
            for (int ks = 0; ks < 4; ++ks) yv = MFMA32(*(const LAS bf16x8*)(S0cur + (32 * im + r32) * KP + 16 * ks + 8 * hh), *(const LAS bf16x8*)(Rt + (32 * tn + r32) * KP + 16 * ks + 8 * hh), yv);
#pragma unroll
            for (int ks = 0; ks < 4; ++ks) yv = MFMA32(trfrag(Vn + im * 2048 + 16 * ks * 32 + troff, 128), *(const LAS bf16x8*)(Ark + (32 * tn + r32) * KP + 16 * ks + 8 * hh), yv); }
        BARL();
        if (SKIP & 16) {} else if (wave < 4) { const int jm = (wave >> 1) & 1, inn = wave & 1;
#pragma unroll
            for (int rq = 0; rq < 4; ++rq) { const f32x4 l4 = *(const LAS f32x4*)(Lc + 32 * jm + 8 * rq + 4 * hh);
#pragma unroll
                for (int e = 0; e < 4; ++e) sacc[4 * rq + e] *= l4[e]; }
#pragma unroll
            for (int ks = 0; ks < 4; ++ks) { const bf16x8 bf = *(const LAS bf16x8*)(SAt + (32 * inn + r32) * KP + 16 * ks + 8 * hh); sacc = MFMA32(trfrag(Bh + jm * 2048 + 16 * ks * 32 + troff, 128), bf, sacc); }
#pragma unroll
            for (int ks = 0; ks < 4; ++ks) sacc = MFMA32(trfrag(Kh + jm * 2048 + 16 * ks * 32 + troff, 128), trfrag(Vn + inn * 2048 + 16 * ks * 32 + troff, 128), sacc);
            store_tile_nm(S0nxt, sacc, 32 * inn + r32, 32 * jm, hh);
        } else { const int im = (wave >> 1) & 1, tn = wave & 1;
#pragma unroll
            for (int ks = 0; ks < 4; ++ks) yv = MFMA32(*(const LAS bf16x8*)(SAt + (32 * im + r32) * KP + 16 * ks + 8 * hh), *(const LAS bf16x8*)(Arb + (32 * tn + r32) * KP + 16 * ks + 8 * hh), yv);
            float s1 = 0.f, s2 = 0.f;
#pragma unroll
            for (int r = 0; r < 16; ++r) { s1 += yv[r]; s2 += yv[r] * yv[r]; }
            s1 += __shfl_xor(s1, 32); s2 += __shfl_xor(s2, 32);
            if (hh == 0) { ST[((im * 2 + tn) * 32 + r32) * 2] = s1; ST[((im * 2 + tn) * 32 + r32) * 2 + 1] = s2; }
            mean = s1; rstd = s2; }
        BARL();
        if (wave >= 4) { const int im = (wave >> 1) & 1, tn = wave & 1;
            const float o1 = ST[(((im ^ 1) * 2 + tn) * 32 + r32) * 2], o2 = ST[(((im ^ 1) * 2 + tn) * 32 + r32) * 2 + 1];
            const float mu_ = (mean + o1) * (1.0f / 64.0f); const float var = (rstd + o2) * (1.0f / 64.0f) - mu_ * mu_; const float rs_ = __builtin_amdgcn_rsqf(fmaxf(var, 0.f) + 64e-5f);
            const int t = 32 * tn + r32; const float bon = BON[t]; const size_t rowo = (size_t)(row0 + c * 64 + t) * RW;
#pragma unroll
            for (int rq = 0; rq < 4; ++rq) { const int i0 = 32 * im + 8 * rq + 4 * hh, cch = h * 64 + i0;
                const f32x4 g4 = *(const LAS f32x4*)(CT + 768 + i0), b4 = *(const LAS f32x4*)(CT + 832 + i0);
                const u32x2_t vw = *(const LAS u32x2_t*)(Vn + (i0 >> 5) * 2048 + t * 32 + (i0 & 31)); const u32x2_t gw = gq[rq];
                const float v0 = bflo(vw.x), v1 = bfhi(vw.x), v2 = bflo(vw.y), v3 = bfhi(vw.y);
                const float y0 = ((yv[4 * rq + 0] - mu_) * rs_ * g4[0] + b4[0] + bon * v0) * bflo(gw.x), y1 = ((yv[4 * rq + 1] - mu_) * rs_ * g4[1] + b4[1] + bon * v1) * bfhi(gw.x);
                const float y2 = ((yv[4 * rq + 2] - mu_) * rs_ * g4[2] + b4[2] + bon * v2) * bflo(gw.y), y3 = ((yv[4 * rq + 3] - mu_) * rs_ * g4[3] + b4[3] + bon * v3) * bfhi(gw.y);
                u32x2_t w; w.x = cvtpk(y0, y1); w.y = cvtpk(y2, y3); if (DRY) asm volatile("" :: "v"(w.x), "v"(w.y)); else *(GAS u32x2_t*)(GO + rowo + cch) = w; } }
    }
    const int lane = tid0 & 63, r32 = lane & 31, hh = lane >> 5;
    if (wave < 4) { const int jm = (wave >> 1) & 1, inn = wave & 1; float* so = a.out + O_PWKV + ((size_t)(b * 8 + h) * 64 + 32 * inn + r32) * 64 + 32 * jm + 4 * hh;
#pragma unroll
        for (int rq = 0; rq < 4; ++rq) *(GAS f32x4*)(so + 8 * rq) = (f32x4){sacc[4 * rq + 0], sacc[4 * rq + 1], sacc[4 * rq + 2], sacc[4 * rq + 3]}; }
    __syncthreads();
}

__device__ __forceinline__ void conv_fix_block(Frame& F, const Args& a, int blk, __amdgpu_buffer_rsrc_t wsr) {
    unsigned char* ws = a.ws;
    bf16* ACT = (bf16*)(ws + WS_UV); const float* CP = (const float*)(ws + WS_CP); const float* UVS = (const float*)(ws + WS_UVS); const float* UL = (const float*)(ws + WS_UL);
    const float* cw = a.in[27]; float* out = a.out;
    constexpr int CH = DFF / 8;
    int t0 = F.tid; asm volatile("" : "+v"(t0));
    for (int it = t0; it < 2 * CH; it += 512) {
        const int n0 = (it % CH) * 8, rr = it / CH;
        if ((blk & 31) == 31) { const float* u = UL + ((size_t)blk * 2 + rr) * DFF + n0; float* dst = out + O_PCONV + ((size_t)(blk >> 5) * 2 + rr) * DFF + n0;
            *(GAS f32x4*)dst = *(const GAS f32x4*)u; *(GAS f32x4*)(dst + 4) = *(const GAS f32x4*)(u + 4); }
        if ((blk & 31) == 0) continue;
        float c8[8], uv8[8], um1[8], um2[8];
        { const float* p = CP + ((size_t)blk * 2 + rr) * DFF + n0; const f32x4 a0 = *(const GAS f32x4*)p, a1 = *(const GAS f32x4*)(p + 4);
          const float* q = UVS + ((size_t)blk * 2 + rr) * DFF + n0; const f32x4 b0 = *(const GAS f32x4*)q, b1 = *(const GAS f32x4*)(q + 4);
          const float* u1 = UL + ((size_t)(blk - 1) * 2 + 1) * DFF + n0; const f32x4 c0 = *(const GAS f32x4*)u1, c1 = *(const GAS f32x4*)(u1 + 4);
          const float* u2 = UL + ((size_t)(blk - 1) * 2 + 0) * DFF + n0; const f32x4 d0 = *(const GAS f32x4*)u2, d1 = *(const GAS f32x4*)(u2 + 4);
#pragma unroll
          for (int e = 0; e < 4; ++e) { c8[e] = a0[e]; c8[4 + e] = a1[e]; uv8[e] = b0[e]; uv8[4 + e] = b1[e]; um1[e] = c0[e]; um1[4 + e] = c1[e]; um2[e] = d0[e]; um2[4 + e] = d1[e]; } }
        float o8[8];
#pragma unroll
        for (int e = 0; e < 8; ++e) { const int n = n0 + e;
            const float c = c8[e] + (rr == 0 ? cw[n] * um2[e] + cw[DFF + n] * um1[e] : cw[n] * um1[e]);
            const float z = c * (0.7978845608028654f + 0.035677408136300125f * c * c);
            o8[e] = c * __builtin_amdgcn_rcpf(1.0f + __builtin_amdgcn_exp2f(-2.0f * LOG2E * z)) * uv8[e]; }
        pg8::st_wt(wsr, (unsigned)(WS_UV + ((size_t)(blk * 64 + rr) * DFF + n0) * 2), packf8(o8));
    }
}

__device__ __forceinline__ void norm_tile(Frame& F, const Args& a, int pm, int pn, unsigned* pc, LAS float* RST) {
    int t0 = F.tid; asm volatile("" : "+v"(t0));
    const float* SS3 = (const float*)(a.ws + WS_SS3); const bf16* X2 = (const bf16*)(a.ws + WS_BUFA);
    if (t0 < 64) { unsigned sp = 0;
        while ((unsigned)__builtin_amdgcn_readfirstlane(__hip_atomic_load(pc + pm * 32, RLX_AGENT)) < 4u) { __builtin_amdgcn_s_sleep(2); if (++sp > (1u << 22)) { if (t0 == 0) __hip_atomic_store(F.ctl + CW_TMO, 1u, RLX_AGENT); break; } } }
    __syncthreads();
    if (t0 < 256) { const float* sp = SS3 + (size_t)(pm * 256 + t0) * 16; float q = 0.f;
#pragma unroll
        for (int j = 0; j < 16; ++j) q += __hip_atomic_load(sp + j, RLX_AGENT);
        RST[t0] = __builtin_amdgcn_rsqf(q * (1.0f / DM) + 1e-6f); }
    __syncthreads();
    const int c8 = pn * 256 + (t0 & 31) * 8, r0 = t0 >> 5;
    const GAS f32x4* gp = (const GAS f32x4*)(a.in[30] + c8); const f32x4 g0 = gp[0], g1 = gp[1];
#pragma unroll 4
    for (int i = 0; i < 16; ++i) { const int r = r0 + 16 * i; const size_t row = (size_t)pm * 256 + r;
        float x[8]; unpack8(__builtin_nontemporal_load((const GAS v4u*)(X2 + row * DM + c8)), x); const float rs = RST[r];
        GAS f32x4* yr = (GAS f32x4*)(a.out + row * DM + c8);
        __builtin_nontemporal_store((f32x4){x[0], x[1], x[2], x[3]} * rs * g0, &yr[0]); __builtin_nontemporal_store((f32x4){x[4], x[5], x[6], x[7]} * rs * g1, &yr[1]); }
    __syncthreads();
}

__device__ __forceinline__ void final_norm(Frame& F, const Args& a) {
    const float* SS3 = (const float*)(a.ws + WS_SS3); const float* fg = a.in[30]; const bf16* X2 = (const bf16*)(a.ws + WS_BUFA);
    const int gw = F.vcu * NWAVES + F.wave, NGW = F.G * NWAVES;
    f32x4 gv[4];
    { const GAS f32x4* gp = (const GAS f32x4*)fg; gv[0] = gp[2 * F.lane]; gv[1] = gp[2 * F.lane + 1]; gv[2] = gp[128 + 2 * F.lane]; gv[3] = gp[128 + 2 * F.lane + 1]; }
    for (int m = MP + gw; m < M; m += NGW) {
        const GAS v4u* xr = (const GAS v4u*)(X2 + (size_t)m * DM); float x0[8], x1[8]; unpack8(xr[F.lane], x0); unpack8(xr[64 + F.lane], x1);
        const GAS f32x4* sl = (const GAS f32x4*)((const float*)(a.ws + WS_UG) + (size_t)(m - MP) * DM);
#pragma unroll
        for (int z = 0; z < 11; ++z) { const GAS f32x4* p = sl + (size_t)z * 1024 * 256; const f32x4 a0 = p[2 * F.lane], a1 = p[2 * F.lane + 1], a2 = p[128 + 2 * F.lane], a3 = p[128 + 2 * F.lane + 1];
#pragma unroll
            for (int e = 0; e < 4; ++e) { x0[e] += a0[e]; x0[4 + e] += a1[e]; x1[e] += a2[e]; x1[4 + e] += a3[e]; } }
        float q = 0.f;
#pragma unroll
        for (int e = 0; e < 8; ++e) q += x0[e] * x0[e] + x1[e] * x1[e];
        const float rs = 1.0f / sqrtf(wave_sum(q) * (1.0f / DM) + 1e-6f);
        GAS f32x4* yr = (GAS f32x4*)(a.out + (size_t)m * DM);
        yr[2 * F.lane] = (f32x4){x0[0], x0[1], x0[2], x0[3]} * rs * gv[0]; yr[2 * F.lane + 1] = (f32x4){x0[4], x0[5], x0[6], x0[7]} * rs * gv[1];
        yr[128 + 2 * F.lane] = (f32x4){x1[0], x1[1], x1[2], x1[3]} * rs * gv[2]; yr[128 + 2 * F.lane + 1] = (f32x4){x1[4], x1[5], x1[6], x1[7]} * rs * gv[3];
    }
}

__device__ __forceinline__ void sub_barrier(gu32* cnt, gu32* tmo, unsigned n) {
    asm volatile("s_waitcnt vmcnt(0)" ::: "memory"); __syncthreads();
    if (threadIdx.x == 0) {
        __builtin_amdgcn_fence(__ATOMIC_RELEASE, "agent"); asm volatile("s_waitcnt vmcnt(0)" ::: "memory");
        __hip_atomic_fetch_add(cnt, 1u, RLX_AGENT);
        unsigned sp = 0;
        while (__hip_atomic_load(cnt, RLX_AGENT) < n) { __builtin_amdgcn_s_sleep(2); if (++sp > (1u << 22)) { __hip_atomic_store(tmo, 1u, RLX_AGENT); break; } }
        __builtin_amdgcn_fence(__ATOMIC_ACQUIRE, "agent"); asm volatile("s_waitcnt vmcnt(0)" ::: "memory");
    }
    __syncthreads();
}

__global__ void __launch_bounds__(NWAVES * 64, 2) fwd(Args args) {
    extern __shared__ __attribute__((aligned(16))) unsigned char lds[];
    Frame F;
    F.lds = (LAS unsigned char*)lds;
    F.MISC = (volatile LAS unsigned*)(F.lds + MISC_OFF);
    F.tid = threadIdx.x; F.lane = F.tid & 63; F.wave = __builtin_amdgcn_readfirstlane(F.tid >> 6);
    F.G = gridDim.x; { const int bx = blockIdx.x; F.vcu = (F.G % 8 == 0) ? (bx % 8) * (F.G / 8) + bx / 8 : bx; }
    unsigned char* ws = args.ws;
    F.ctl = (gu32*)(ws + WS_CTL);
    for (int u = F.tid; u < (LDS_BYTES - LDSCTL_OFF) / 4; u += NWAVES * 64) ((LAS unsigned*)(F.lds + LDSCTL_OFF))[u] = 0u;
    __syncthreads();
    XcdBarrier bar; bar.bar = (unsigned*)(F.ctl + CW_BAR); bar.x = 0; bar.st = nullptr;
    if (N_LAUNCHES == 1) bar = xcd_barrier_post((unsigned*)(F.ctl + CW_BAR), F.MISC + 8);
#define GRID_BAR() do { if (N_LAUNCHES == 1) xcd_barrier(bar); } while (0)
    const int lo = args.ph_lo, hi = args.ph_hi;
#define IN(k) (lo <= (k) && (k) < hi)
#define BOTH(k) (IN(k) && IN((k) + 1))
    typedef pg8::bf16_t pb;
    if (IN(0)) { p0_prologue(F, args); if (PROBE_DUP == 0) { __syncthreads(); p0_prologue(F, args); } if (BOTH(0)) GRID_BAR(); }
    if (IN(1)) {
        pg8::Gemm g{(const pb*)(ws + WS_BUFA), (const pb*)(ws + WS_WIN), M, INC, DM, DM, DM, 128, 256, 0}; pg8::StaticOrder S; S.init(MP, INC, F.G, (int)blockIdx.x);
        pg8::EpiProj E{(pb*)(ws + WS_QKV), (pb*)(ws + WS_RWB), ws + WS_GA8, ws + WS_GB, (const float*)(ws + WS_RS1)};
        pg8::gemm_phase<pg8::EpiProj, pg8::StaticOrder, true, true>(F.lds + RING_OFF, g, S, E); if (PROBE_DUP == 1) { __syncthreads(); pg8::gemm_phase<pg8::EpiProj, pg8::StaticOrder, true, true>(F.lds + RING_OFF, g, S, E); }
        if (BOTH(1)) GRID_BAR();
    }
    if (IN(2)) {
        constexpr int NS = (MS / 256) * (INC / 256), NF = 256 - NS, U0 = 5 * NF;
        const int cb = F.vcu - (F.G - NS);
        if (F.G != 256) { rwkv_prep_mfma(F, args, F.vcu, F.G, M / 32); }
        else if (cb < 0) rwkv_prep_mfma(F, args, F.vcu, NF, U0);
        else {
            { pg8::Gemm g{(const pb*)(ws + WS_BUFA), (const pb*)(ws + WS_WIN), M, INC, DM, DM, DM, 128, 256, 0}; pg8::RangeOrder S; S.init(MP / 256, MS / 256, INC, NS, cb);
              pg8::EpiProj E{(pb*)(ws + WS_QKV), (pb*)(ws + WS_RWB), ws + WS_GA8, ws + WS_GB, (const float*)(ws + WS_RS1)};
              pg8::gemm_phase<pg8::EpiProj, pg8::RangeOrder, true, true>(F.lds + RING_OFF, g, S, E); }
            asm volatile("s_waitcnt vmcnt(0)" ::: "memory"); __syncthreads();
            if (F.tid == 0) { __builtin_amdgcn_fence(__ATOMIC_RELEASE, "agent"); asm volatile("s_waitcnt vmcnt(0)" ::: "memory"); __hip_atomic_fetch_add(F.ctl + CW_SUB + 192, 1u, RLX_AGENT);
                unsigned sp = 0; while (__hip_atomic_load(F.ctl + CW_SUB + 192, RLX_AGENT) < (unsigned)NS) { __builtin_amdgcn_s_sleep(2); if (++sp > (1u << 22)) { __hip_atomic_store(F.ctl + CW_TMO, 1u, RLX_AGENT); break; } }
                __builtin_amdgcn_fence(__ATOMIC_ACQUIRE, "agent"); asm volatile("s_waitcnt vmcnt(0)" ::: "memory"); }
            __syncthreads();
            rwkv_prep_mfma(F, args, U0 + cb, NS, M / 32);
        }
        __syncthreads(); p0_weights(F, args, 1, F.vcu * NWAVES + F.wave, F.G * NWAVES);
        if (BOTH(2)) GRID_BAR();
    }
    if (IN(3)) {
        const int GR = F.G / 2, NO = F.G - GR, o = F.vcu - GR;
        if (F.vcu < GR) { for (int u = F.vcu; u < NB * 8; u += GR) { if (PROBE_DUP == 2) rwkv_chunked<true, PROBE_SKIP>(F, args, u >> 3, u & 7); rwkv_chunked<false>(F, args, u >> 3, u & 7); } }
        else { attn_v1(F, args, o, NO); if (PROBE_DUP == 30) { __syncthreads(); attn_v1(F, args, o, NO); }
            sub_barrier(F.ctl + CW_SUB, F.ctl + CW_TMO, (unsigned)NO);
            { pg8::Gemm g{(const pb*)(ws + WS_ATT), (const pb*)(ws + WS_WPA), M, DM, RW, RW, RW, 128, 256, 0}; pg8::StaticOrder S; S.init(M, DM, NO, o);
              pg8::EpiMix1 E{ws + WS_GA8, (pb*)(ws + WS_GA)};
              pg8::gemm_phase<pg8::EpiMix1, pg8::StaticOrder, true, true>(F.lds + RING_OFF, g, S, E); }
            __syncthreads(); for (int k = o; k < DECB; k += NO) { rwkv_scan_sample(F, args, k); __syncthreads(); } }
        if (BOTH(3)) GRID_BAR();
    }
    if (IN(4)) {
        { pg8::Gemm g{(const pb*)(ws + WS_RWO), (const pb*)(ws + WS_WPB), M, DM, RW, RW, RW, 128, 256, 0}; pg8::StaticOrder S; S.init(M, DM, F.G, (int)blockIdx.x);
          pg8::EpiMix2 E{ws + WS_GB, (const pb*)(ws + WS_GA), (pb*)(ws + WS_GA)};
          pg8::gemm_phase<pg8::EpiMix2, pg8::StaticOrder, true, true>(F.lds + RING_OFF, g, S, E); }
        if ((int)blockIdx.x >= 16) { state_copies(F, args, (int)blockIdx.x - 16, F.G - 16); __syncthreads(); p0_weights(F, args, 2, ((int)blockIdx.x - 16) * NWAVES + F.wave, (F.G - 16) * NWAVES); }
        if (BOTH(4)) GRID_BAR();
    }
    if (IN(5)) {
        pg8::Gemm g{(const pb*)(ws + WS_GA), (const pb*)(ws + WS_WO), M, DM, DM, DM, DM, 128, 256, 0}; pg8::StaticOrder S; S.init(MP, DM, F.G, (int)blockIdx.x);
        pg8::EpiWo E{(pb*)(ws + WS_BUFA), (float*)(ws + WS_SS2)};
        pg8::gemm_phase<pg8::EpiWo, pg8::StaticOrder, true, true>(F.lds + RING_OFF, g, S, E); if (PROBE_DUP == 5) { __syncthreads(); pg8::gemm_phase<pg8::EpiWo, pg8::StaticOrder, true, true>(F.lds + RING_OFF, g, S, E); }
        if (BOTH(5)) GRID_BAR();
    }
    if (IN(6)) {
        const int cs = ((((int)blockIdx.x >> 3) >> 3) == 3 && ((((int)blockIdx.x >> 3) & 7) == 2 || (((int)blockIdx.x >> 3) & 7) == 3)) ? ((int)blockIdx.x & 7) * 2 + ((((int)blockIdx.x >> 3) & 7) == 3) : -1;
        if (cs >= 0) {
            { pg8::Gemm g{(const pb*)(ws + WS_GA), (const pb*)(ws + WS_WO), M, DM, DM, DM, DM, 128, 256, 0}; pg8::RangeOrder S; S.init(MP / 256, MS / 256, DM, 16, cs);
              pg8::EpiWo E{(pb*)(ws + WS_BUFA), (float*)(ws + WS_SS2)};
              pg8::gemm_phase<pg8::EpiWo, pg8::RangeOrder, true, true>(F.lds + RING_OFF, g, S, E); }
            asm volatile("s_waitcnt vmcnt(0)" ::: "memory"); __syncthreads();
            if (F.tid == 0) { __builtin_amdgcn_fence(__ATOMIC_RELEASE, "agent"); asm volatile("s_waitcnt vmcnt(0)" ::: "memory"); __hip_atomic_fetch_add(F.ctl + CW_SUB + 64, 1u, RLX_AGENT); }
            __syncthreads();
        }
#define DF_IDS() int c = (int)blockIdx.x; asm volatile("" : "+s"(c)); const int x = c & 7, w = c >> 3, p_ = w & 7, q_ = w >> 3; const bool late = (q_ == 3) && (p_ == 2 || p_ == 3), busy = (p_ < 2) || (p_ == 2 && q_ < 3), idle = !late && !busy; \
        const int bl = (p_ < 2) ? p_ * 4 + q_ : 8 + q_, bi = x * 11 + bl;                         \
        const int ir = (q_ < 3) ? q_ * 5 + (p_ - 3) : 15 + (p_ - 4), ii = x * 19 + ir;              \
        const int nl = busy ? bl : 11 + ir;                                                         \
        (void)x; (void)w; (void)late; (void)busy; (void)idle; (void)bi; (void)ii; (void)nl; (void)ir; \
        unsigned* tmo = (unsigned*)(F.ctl + CW_TMO); (void)tmo
#define DF_CNT(k) ((unsigned*)(F.ctl + CW_DF + (k) * 32))
        const __amdgpu_buffer_rsrc_t wsr = __builtin_amdgcn_make_buffer_rsrc(ws, 0, (int)WS_END, 0x00020000);
        {
            DF_IDS(); const unsigned nA = (w < 16) ? 6u : 5u;
            pg8::Gemm g{(const pb*)(ws + WS_BUFA), (const pb*)(ws + WS_WUP), M, 2 * DFF, DM, DM, DM, DFF, 128, 0};
            pg8::UpOrder S; S.so.init(MP, 2 * DFF, F.G, c); S.mode = 0; S.spm = 0; S.spn = 0; S.wcnt = nullptr; S.wneed = 0u; S.tmo = tmo;
            S.pub_round = late ? (int)nA - 1 : -2; S.pub_n = nA; S.pub_cnt = DF_CNT(2 * x);
            LAS float* RSL = (LAS float*)(F.lds + RING_BYTES);
            { pg8::Unit u; const float* ss2 = (const float*)(ws + WS_SS2); const int r = F.tid & 255;
              for (int i = F.tid >> 8; S.next(i, u); i += 2) { const GAS f32x4* sp = (const GAS f32x4*)(ss2 + (size_t)(u.pm * 256 + r) * 16);
                  const f32x4 s0 = sp[0], s1 = sp[1], s2 = sp[2], s3 = sp[3]; const f32x4 st = (s0 + s1) + (s2 + s3);
                  RSL[i * 256 + r] = __builtin_amdgcn_rsqf(((st[0] + st[1]) + (st[2] + st[3])) * (1.0f / 1024.0f) + 1e-6f); }
              __syncthreads(); }
            pg8::EpiUpAct E{(pb*)(ws + WS_UV), (const float*)(ws + WS_SS2), args.in[27], args.in[28], args.in[6], (float*)(ws + WS_CP), (float*)(ws + WS_UVS), (float*)(ws + WS_UL), args.out + O_SCONV, MP, wsr, (unsigned)WS_UV, (unsigned)WS_CP, (unsigned)WS_UVS, (unsigned)WS_UL, (const PG8_LAS float*)RSL};
            pg8::gemm_phase<pg8::EpiUpAct, pg8::UpOrder, true, true>(F.lds + RING_OFF, g, S, E);
        }
        {
            DF_IDS(); const unsigned nA = (w < 16) ? 6u : 5u;
            pg8::wg_publish_wt(DF_CNT(2 * x), late ? 0u : nA, DF_CNT(2 * x + 1), 11u - nA);
            if (!late) {
                pg8::wg_wait(DF_CNT(2 * x), 176u, tmo);
                conv_fix_block(F, args, 64 * x + nl + 1, wsr); if (nl == 0) conv_fix_block(F, args, 64 * x + 31, wsr);
                pg8::wg_publish_wt(DF_CNT(16 + 2 * x), 1u, nullptr, 0u);
            }
            if (busy) {
                pg8::Gemm g{(const pb*)(ws + WS_BUFA), (const pb*)(ws + WS_WUP), M, 2 * DFF, DM, DM, DM, DFF, 128, 0};
                pg8::UpOrder S; S.so.init(MP, 2 * DFF, F.G, c); S.mode = 1; S.spm = MP / 256 + bi / 22; S.spn = bi % 22; S.wcnt = (unsigned*)(F.ctl + CW_SUB + 64); S.wneed = 16u; S.tmo = tmo; S.pub_round = -2; S.pub_n = 0u; S.pub_cnt = nullptr;
                pg8::EpiUpAct E{(pb*)(ws + WS_UV), (const float*)(ws + WS_SS2), args.in[27], args.in[28], args.in[6], (float*)(ws + WS_CP), (float*)(ws + WS_UVS), (float*)(ws + WS_UL), args.out + O_SCONV, MP, wsr, (unsigned)WS_UV, (unsigned)WS_CP, (unsigned)WS_UVS, (unsigned)WS_UL, (const PG8_LAS float*)(F.lds + RING_BYTES)};
                pg8::gemm_phase<pg8::EpiUpAct, pg8::UpOrder, true, true>(F.lds + RING_OFF, g, S, E);
                pg8::wg_publish(DF_CNT(32), 1u, nullptr, 0u);
            }
        }
#define DF_DOWN(I0, I1) do { DF_IDS(); \
            pg8::Gemm g{(const pb*)(ws + WS_UV), (const pb*)(ws + WS_WDN), M, DM, DFF, DFF, DFF, 128, 256, DFF / 11};        \
            pg8::DownOrder D; D.so.init(MP, DM, F.G, c); D.i0 = (I0); D.i1 = (I1); D.j0 = idle ? ii : -1; D.j1 = (idle && ii < 24) ? ii + 152 : -1; \
            D.w0 = DF_CNT(16 + 2 * x); D.n0 = 30u; D.w1 = DF_CNT(17 + 2 * x); D.n1 = 19u; D.w2 = DF_CNT(32); D.n2 = 88u; D.tmo = tmo; D.pc = DF_CNT(33); \
            pg8::EpiDown E{(pb*)(ws + WS_BUFA), (float*)(ws + WS_SS3), (float*)(ws + WS_UG), MP}; \
            pg8::gemm_phase<pg8::EpiDown, pg8::DownOrder, true, true>(F.lds + RING_OFF, g, D, E); } while (0)
        DF_DOWN(0, 1);
        {
            DF_IDS();
            if (idle) {
                pg8::wg_wait(DF_CNT(2 * x + 1), 176u, tmo);
                const int k = ir; conv_fix_block(F, args, 64 * x + 32 + k + 1, wsr); if (k <= 11) conv_fix_block(F, args, 64 * x + 32 + k + 20, wsr);
                pg8::wg_publish_wt(DF_CNT(17 + 2 * x), 1u, nullptr, 0u);
            }
        }
        DF_DOWN(1, 4);
        {
            DF_IDS(); pg8::StaticOrder so; so.init(MP, DM, F.G, c); pg8::Unit u; LAS float* RST = (LAS float*)(F.lds + RING_BYTES + 12288);
            so.next(0, u); norm_tile(F, args, u.pm, u.pn, DF_CNT(33), RST);
            so.next(1, u); norm_tile(F, args, u.pm, u.pn, DF_CNT(33), RST);
        }
#undef DF_DOWN
#undef DF_CNT
#undef DF_IDS
        if (BOTH(6)) GRID_BAR();
    }
    if (IN(9)) { final_norm(F, args); if (PROBE_DUP == 9) { __syncthreads(); final_norm(F, args); } }
#undef IN
#undef BOTH
}

extern "C" void kernel_launch(void* const* d_in, const int* in_sizes, int n_in, void* d_out, int out_size, void* d_ws, size_t ws_size, hipStream_t stream) {
    static int grid = 0;
    if (grid == 0) {
        if (n_in != 31 || out_size != 45109248 || ws_size < WS_END) { fprintf(stderr, "kernel_launch: unexpected shapes n_in %d out %d ws %zu\n", n_in, out_size, ws_size); grid = -1; return; }
        int dev = 0, cus = 0, per_cu = 0;
        if (hipGetDevice(&dev) != hipSuccess || hipDeviceGetAttribute(&cus, hipDeviceAttributeMultiprocessorCount, dev) != hipSuccess) { grid = -1; return; }
        if (hipFuncSetAttribute((const void*)fwd, hipFuncAttributeMaxDynamicSharedMemorySize, LDS_BYTES) != hipSuccess) { fprintf(stderr, "kernel_launch: hipFuncSetAttribute failed\n"); grid = -1; return; }
        if (hipOccupancyMaxActiveBlocksPerMultiprocessor(&per_cu, (const void*)fwd, NWAVES * 64, LDS_BYTES) != hipSuccess || per_cu < 1) fprintf(stderr, "kernel_launch: occupancy query says %d\n", per_cu);
        (void)hipGetLastError();
        grid = cus;
    }
    if (grid < 0) return;
    (void)hipMemsetAsync((char*)d_ws + WS_CTL, 0, CTL_ZERO_BYTES, stream);
    Args a{};
    for (int i = 0; i < 31; ++i) a.in[i] = (const float*)d_in[i];
    a.out = (float*)d_out; a.ws = (unsigned char*)d_ws;
    if (N_LAUNCHES == 1) { a.ph_lo = 0; a.ph_hi = NPH; a.li = 0; hipLaunchKernelGGL(fwd, dim3(grid), dim3(NWAVES * 64), LDS_BYTES, stream, a); }
    else { for (int li = 0; li < NPH; ++li) { a.ph_lo = li; a.ph_hi = li + 1; a.li = li; hipLaunchKernelGGL(fwd, dim3(grid), dim3(NWAVES * 64), LDS_BYTES, stream, a); } }
}
```

```cpp
#include <hip/hip_runtime.h>
#include <cstdio>
#include <cstdint>
#include <cmath>
namespace pg8 {
#define PG8_LAS __attribute__((address_space(3)))
typedef unsigned short bf16_t;
typedef short bf16x8 __attribute__((ext_vector_type(8)));
typedef float f32x4 __attribute__((ext_vector_type(4)));
typedef unsigned u32x4 __attribute__((ext_vector_type(4)));
constexpr int BM = 256, BK = 64, HALF = 128, HTB = HALF * BK * 2  , STAGE_BYTES = 8 * HTB, NXCD = 8, WGM = 8;

__host__ __device__ __forceinline__ int lds_byte(int r, int c) { const int st = (r >> 4) * 2 + (c >> 5), rr = r & 15, cc = c & 31, ob = rr * 64 + cc * 2; return st * 1024 + (ob ^ (((ob >> 9) & 1) << 5)); }
__host__ __device__ __forceinline__ void stage_rc(int b, int& R, int& C) { const int st = b / 1024, sb = b % 1024, swz = sb ^ (((sb >> 9) & 1) << 5); R = (st >> 1) * 16 + swz / 64; C = (st & 1) * 32 + (swz % 64) / 2; }
__host__ __device__ __forceinline__ int perm32(int rho) { const int n = rho >> 4, i = rho & 15; return 8 * (i >> 2) + 4 * n + (i & 3); }

struct Unit { int pm, pn, kz; };
struct Gemm { const bf16_t* A; const bf16_t* Bt; int M, N, K; int lda, ldb; int bhalf_rows, btile_rows; int ksplit; };

struct StaticOrder {
    int nM, nN, nwg, G, c;
    __host__ __device__ void init(int M, int N, int G_, int c_) { nM = M / BM; nN = N / BM; nwg = nM * nN; G = G_; c = c_; }
    __host__ __device__ __forceinline__ bool next(int i, Unit& u) const {
        const long L = (long)i * G + c; if (L >= nwg) return false;
        int wgid = (int)L; { const int q = nwg / NXCD, r = nwg % NXCD, xcd = wgid % NXCD, off = wgid / NXCD; wgid = (xcd < r ? xcd * (q + 1) : r * (q + 1) + (xcd - r) * q) + off; }
        const int nig = WGM * nN, gid = wgid / nig, fm = gid * WGM, gsz = (nM - fm) < WGM ? (nM - fm) : WGM;
        u.pm = fm + ((wgid % nig) % gsz); u.pn = (wgid % nig) / gsz; u.kz = -1; return true;
    }
    __device__ __forceinline__ void a_ready(const Unit&) const {}
    __device__ __forceinline__ void done(const Unit&) const {}
};
struct ProjOrder : StaticOrder {
    __device__ __forceinline__ bool next(int i, Unit& u) const { const bool ok = StaticOrder::next(i, u); const int j = u.pn; u.pn = (j >= 16) ? j - 8 : (j & 1) ? 10 + (j >> 1) : (j >> 1); return ok; }
};
struct SplitTailOrder {
    StaticOrder so; int nN, ks, ntail, tail_pm0, G, c, rounds;
    __host__ __device__ void init(int mainM, int M, int N, int ksn, int G_, int c_) { so.init(mainM, N, G_, c_); nN = N / BM; ks = ksn; tail_pm0 = mainM / BM; ntail = (M - mainM) / BM * nN * ksn; G = G_; c = c_; rounds = (so.nwg + G_ - 1) / G_; }
    __host__ __device__ bool next(int i, Unit& u) const {
        const int nmain = (c < so.nwg) ? (so.nwg - c + G - 1) / G : 0;
        if (i < nmain) return so.next(i, u);
        const long j = (long)(i - nmain) * G + c; if (j >= ntail) return false;
        u.kz = (int)(j % ks); u.pn = (int)((j / ks) % nN); u.pm = tail_pm0 + (int)(j / ((long)ks * nN)); return true;
    }
    __device__ __forceinline__ void a_ready(const Unit&) const {}
    __device__ __forceinline__ void done(const Unit&) const {}
};

struct RangeOrder {
    int pm0, nN, n, G, c;
    __host__ __device__ void init(int pm0_, int npm, int N, int G_, int c_) { pm0 = pm0_; nN = N / BM; n = npm * nN; G = G_; c = c_; }
    __host__ __device__ bool next(int i, Unit& u) const { const long j = (long)i * G + c; if (c < 0 || j >= n) return false; u.pm = pm0 + (int)(j / nN); u.pn = (int)(j % nN); u.kz = -1; return true; }
    __device__ __forceinline__ void a_ready(const Unit&) const {}
    __device__ __forceinline__ void done(const Unit&) const {}
};
struct WaitOrder : StaticOrder {
    unsigned* cnt; unsigned need; int first_pm; volatile PG8_LAS unsigned* flag; unsigned* tmo;
    __device__ __forceinline__ bool next(int i, Unit& u) const { const bool ok = StaticOrder::next(i, u); u.kz = -1 - i; return ok; }
    __device__ __forceinline__ void a_ready(const Unit& u) const {
        if (u.pm < first_pm) return;
        if (threadIdx.x < 64) {
            if (*flag == 0u) { unsigned sp = 0;
                while ((unsigned)__builtin_amdgcn_readfirstlane(__hip_atomic_load(cnt, __ATOMIC_RELAXED, __HIP_MEMORY_SCOPE_AGENT)) < need) { __builtin_amdgcn_s_sleep(2); if (++sp > (1u << 22)) { if (threadIdx.x == 0) __hip_atomic_store(tmo, 1u, __ATOMIC_RELAXED, __HIP_MEMORY_SCOPE_AGENT); break; } }
                __builtin_amdgcn_fence(__ATOMIC_ACQUIRE, "agent"); asm volatile("s_waitcnt vmcnt(0)" ::: "memory");
                if (threadIdx.x == 0) *flag = 1u; asm volatile("s_waitcnt lgkmcnt(0)" ::: "memory"); }
        }
        asm volatile("" ::: "memory"); __builtin_amdgcn_s_barrier(); asm volatile("" ::: "memory");
    }
};

__device__ __forceinline__ void wg_wait(unsigned* cnt, unsigned need, unsigned* tmo) {
    if (threadIdx.x < 64) { unsigned sp = 0;
        while ((unsigned)__builtin_amdgcn_readfirstlane(__hip_atomic_load(cnt, __ATOMIC_RELAXED, __HIP_MEMORY_SCOPE_AGENT)) < need) { __builtin_amdgcn_s_sleep(2); if (++sp > (1u << 22)) { if (threadIdx.x == 0) __hip_atomic_store(tmo, 1u, __ATOMIC_RELAXED, __HIP_MEMORY_SCOPE_AGENT); break; } }
        __builtin_amdgcn_fence(__ATOMIC_ACQUIRE, "agent"); asm volatile("s_waitcnt vmcnt(0)" ::: "memory"); }
    asm volatile("" ::: "memory"); __builtin_amdgcn_s_barrier(); asm volatile("" ::: "memory");
}
__device__ __forceinline__ void wg_publish(unsigned* c0, unsigned n0, unsigned* c1, unsigned n1) {
    asm volatile("s_waitcnt vmcnt(0)" ::: "memory"); __builtin_amdgcn_s_barrier(); asm volatile("" ::: "memory");
    if (threadIdx.x == 0) { __builtin_amdgcn_fence(__ATOMIC_RELEASE, "agent"); asm volatile("s_waitcnt vmcnt(0)" ::: "memory");
        if (n0) __hip_atomic_fetch_add(c0, n0, __ATOMIC_RELAXED, __HIP_MEMORY_SCOPE_AGENT);
        if (n1) __hip_atomic_fetch_add(c1, n1, __ATOMIC_RELAXED, __HIP_MEMORY_SCOPE_AGENT); }
}
__device__ __forceinline__ void wg_publish_wt(unsigned* c0, unsigned n0, unsigned* c1, unsigned n1) {
    asm volatile("s_waitcnt vmcnt(0)" ::: "memory"); __builtin_amdgcn_s_barrier(); asm volatile("" ::: "memory");
    if (threadIdx.x == 0) {
        if (n0) __hip_atomic_fetch_add(c0, n0, __ATOMIC_RELAXED, __HIP_MEMORY_SCOPE_AGENT);
        if (n1) __hip_atomic_fetch_add(c1, n1, __ATOMIC_RELAXED, __HIP_MEMORY_SCOPE_AGENT); }
}
__device__ __forceinline__ void st_wt(__amdgpu_buffer_rsrc_t r, unsigned byte_off, u32x4 v) { __builtin_amdgcn_raw_buffer_store_b128(v, r, byte_off, 0,   16); }
__device__ __forceinline__ void st_wt(__amdgpu_buffer_rsrc_t r, unsigned byte_off, f32x4 v) { __builtin_amdgcn_raw_buffer_store_b128(__builtin_bit_cast(u32x4, v), r, byte_off, 0, 16); }
struct UpOrder {
    StaticOrder so; int mode, spm, spn; unsigned* wcnt; unsigned wneed; unsigned* tmo; int pub_round; unsigned pub_n; unsigned* pub_cnt;
    __device__ __forceinline__ bool next(int i, Unit& u) const {
        if (mode == 0) { const bool ok = so.next(i, u); u.kz = -1 - i; return ok; }
        if (i > 0) return false;
        u.pm = spm; u.pn = spn; u.kz = -1; return true;
    }
    __device__ __forceinline__ void a_ready(const Unit&) const { if (mode == 1) wg_wait(wcnt, wneed, tmo); }
    __device__ __forceinline__ void done(const Unit& u) const { if (mode == 0 && pub_round == -1 - u.kz) wg_publish_wt(pub_cnt, pub_n, pub_cnt, 0u); }
};
struct DownOrder {
    StaticOrder so; int i0, i1, j0, j1; unsigned *w0, *w1, *w2; unsigned n0, n1, n2; unsigned* tmo; unsigned* pc;
    __device__ __forceinline__ bool next(int i, Unit& u) const {
        const int k = i0 + i; if (k >= i1) return false;
        if (k < 2) return so.next(k, u);
        const int j = (k == 2) ? j0 : j1; if (j < 0) return false;
        u.kz = j % 11; u.pn = (j / 11) & 3; u.pm = so.nM + j / 44; return true;
    }
    __device__ __forceinline__ void a_ready(const Unit& u) const {
        if (u.kz >= 0) wg_wait(w2, n2, tmo); else if (u.pm & 8) wg_wait(w1, n1, tmo); else wg_wait(w0, n0, tmo);
    }
    __device__ __forceinline__ void done(const Unit& u) const {
        if (u.kz >= 0) return;
        asm volatile("s_waitcnt vmcnt(0)" ::: "memory"); __builtin_amdgcn_s_barrier(); asm volatile("" ::: "memory");
        if (threadIdx.x == 0) __hip_atomic_fetch_add(pc + u.pm * 32, 1u, __ATOMIC_RELAXED, __HIP_MEMORY_SCOPE_AGENT);
    }
};

__device__ __forceinline__ unsigned cvt_pk_bf16(float lo, float hi) { unsigned r; asm volatile("v_cvt_pk_bf16_f32 %0, %1, %2" : "=v"(r) : "v"(lo), "v"(hi)); return r; }
__device__ __forceinline__ float bflo(unsigned w) { return __builtin_bit_cast(float, w << 16); }
__device__ __forceinline__ float bfhi(unsigned w) { return __builtin_bit_cast(float, w & 0xffff0000u); }
__device__ __forceinline__ float sigmoidf_fast(float x) { return __builtin_amdgcn_rcpf(1.0f + __builtin_amdgcn_exp2f(-1.4426950408889634f * x)); }
__device__ __forceinline__ u32x4 pack8(const f32x4& v0, const f32x4& v1) { u32x4 w; w.x = cvt_pk_bf16(v0[0], v0[1]); w.y = cvt_pk_bf16(v0[2], v0[3]); w.z = cvt_pk_bf16(v1[0], v1[1]); w.w = cvt_pk_bf16(v1[2], v1[3]); return w; }

struct EpiProj {
    static constexpr bool PERM = true, AFTER_DRAIN = false;
    bf16_t *qkv, *rwb; unsigned char *ga8, *gb8; const float* rs;
    __device__ __forceinline__ void operator()(const f32x4 (&acc)[2][2][4][2], const Unit& u, int wr, int wc, int fr, int fq) const {
        typedef unsigned u32x2 __attribute__((ext_vector_type(2)));
        const int pn = u.pn; const int row0 = u.pm * BM + wr * 64 + fr;
        if (pn < 10) { bf16_t* base; int ld, colt;
            if (pn < 3) { base = qkv; ld = 768; colt = pn * 256; } else { base = rwb; ld = 1792; colt = (pn - 3) * 256; }
            const int col0 = colt + wc * 32 + 8 * fq;
#pragma unroll
            for (int ai = 0; ai < 2; ++ai)
#pragma unroll
                for (int m = 0; m < 4; ++m) { const int row = row0 + ai * HALF + m * 16; const float s = rs[row]; bf16_t* rowp = base + (size_t)row * ld + col0;
#pragma unroll
                    for (int bj = 0; bj < 2; ++bj) { const f32x4 v0 = acc[ai][bj][m][0] * s, v1 = acc[ai][bj][m][1] * s; *(u32x4*)(rowp + bj * HALF) = pack8(v0, v1); } }
        } else { unsigned char* base = (pn < 14) ? ga8 : gb8; const int col0 = ((pn < 14) ? pn - 10 : pn - 14) * 256 + wc * 32 + 8 * fq;
#pragma unroll
            for (int ai = 0; ai < 2; ++ai)
#pragma unroll
                for (int m = 0; m < 4; ++m) { const int row = row0 + ai * HALF + m * 16; const float sm = -1.4426950408889634f * rs[row]; unsigned char* rowp = base + (size_t)row * 1024 + col0;
#pragma unroll
                    for (int bj = 0; bj < 2; ++bj) { u32x2 w = {0u, 0u};
#pragma unroll
                        for (int e = 0; e < 4; ++e) {
                            const float g0 = __builtin_amdgcn_rcpf((1.0f / 255.0f) + __builtin_amdgcn_exp2f(__builtin_fmaf(acc[ai][bj][m][0][e], sm, -7.994353436858858f)));
                            const float g1 = __builtin_amdgcn_rcpf((1.0f / 255.0f) + __builtin_amdgcn_exp2f(__builtin_fmaf(acc[ai][bj][m][1][e], sm, -7.994353436858858f)));
                            w.x = __builtin_amdgcn_cvt_pk_u8_f32(g0, e, w.x); w.y = __builtin_amdgcn_cvt_pk_u8_f32(g1, e, w.y); }
                        *(u32x2*)(rowp + bj * HALF) = w; } }
        }
    }
};
__device__ __forceinline__ float ub0(unsigned w) { return (float)(w & 0xffu); }
__device__ __forceinline__ float ub1(unsigned w) { return (float)((w >> 8) & 0xffu); }
__device__ __forceinline__ float ub2(unsigned w) { return (float)((w >> 16) & 0xffu); }
__device__ __forceinline__ float ub3(unsigned w) { return (float)(w >> 24); }
struct EpiMix1 {
    static constexpr bool PERM = true, AFTER_DRAIN = false;
    const unsigned char* ga8; bf16_t* p1;
    __device__ __forceinline__ void operator()(const f32x4 (&acc)[2][2][4][2], const Unit& u, int wr, int wc, int fr, int fq) const {
        typedef unsigned u32x2 __attribute__((ext_vector_type(2)));
        const int row0 = u.pm * BM + wr * 64 + fr, col0 = u.pn * BM + wc * 32 + 8 * fq;
#pragma unroll
        for (int ai = 0; ai < 2; ++ai)
#pragma unroll
            for (int m = 0; m < 4; ++m) { const size_t off = (size_t)(row0 + ai * HALF + m * 16) * 1024 + col0;
#pragma unroll
                for (int bj = 0; bj < 2; ++bj) { const u32x2 g = __builtin_nontemporal_load((const u32x2*)(ga8 + off + bj * HALF));
                    f32x4 v0 = acc[ai][bj][m][0] * (1.0f / 255.0f), v1 = acc[ai][bj][m][1] * (1.0f / 255.0f);
                    v0[0] *= ub0(g.x); v0[1] *= ub1(g.x); v0[2] *= ub2(g.x); v0[3] *= ub3(g.x); v1[0] *= ub0(g.y); v1[1] *= ub1(g.y); v1[2] *= ub2(g.y); v1[3] *= ub3(g.y);
                    *(u32x4*)(p1 + off + bj * HALF) = pack8(v0, v1); } }
    }
};
struct EpiMix2 {
    static constexpr bool PERM = true, AFTER_DRAIN = false;
    const unsigned char* gb8; const bf16_t* p1; bf16_t* mix;
    __device__ __forceinline__ void operator()(const f32x4 (&acc)[2][2][4][2], const Unit& u, int wr, int wc, int fr, int fq) const {
        typedef unsigned u32x2 __attribute__((ext_vector_type(2)));
        const int row0 = u.pm * BM + wr * 64 + fr, col0 = u.pn * BM + wc * 32 + 8 * fq;
#pragma unroll
        for (int ai = 0; ai < 2; ++ai)
#pragma unroll
            for (int m = 0; m < 4; ++m) { const size_t off = (size_t)(row0 + ai * HALF + m * 16) * 1024 + col0;
#pragma unroll
                for (int bj = 0; bj < 2; ++bj) { const u32x2 g = __builtin_nontemporal_load((const u32x2*)(gb8 + off + bj * HALF)); const u32x4 p = __builtin_nontemporal_load((const u32x4*)(p1 + off + bj * HALF));
                    f32x4 v0 = acc[ai][bj][m][0] * (1.0f / 255.0f), v1 = acc[ai][bj][m][1] * (1.0f / 255.0f);
                    v0[0] = v0[0] * ub0(g.x) + bflo(p.x); v0[1] = v0[1] * ub1(g.x) + bfhi(p.x); v0[2] = v0[2] * ub2(g.x) + bflo(p.y); v0[3] = v0[3] * ub3(g.x) + bfhi(p.y);
                    v1[0] = v1[0] * ub0(g.y) + bflo(p.z); v1[1] = v1[1] * ub1(g.y) + bfhi(p.z); v1[2] = v1[2] * ub2(g.y) + bflo(p.w); v1[3] = v1[3] * ub3(g.y) + bfhi(p.w);
                    *(u32x4*)(mix + off + bj * HALF) = pack8(v0, v1); } }
    }
};
struct EpiWo {
    static constexpr bool PERM = true, AFTER_DRAIN = false;
    bf16_t* x1; float* ss;
    __device__ __forceinline__ void operator()(const f32x4 (&acc)[2][2][4][2], const Unit& u, int wr, int wc, int fr, int fq) const {
        const int row0 = u.pm * BM + wr * 64 + fr, col0 = u.pn * BM + wc * 32 + 8 * fq;
#pragma unroll
        for (int ai = 0; ai < 2; ++ai)
#pragma unroll
            for (int m = 0; m < 4; ++m) { const int row = row0 + ai * HALF + m * 16; const size_t off = (size_t)row * 1024 + col0;
                float q = 0.f;
#pragma unroll
                for (int bj = 0; bj < 2; ++bj) { const u32x4 xw = *(const u32x4*)(x1 + off + bj * HALF);
                    f32x4 v0 = acc[ai][bj][m][0], v1 = acc[ai][bj][m][1];
                    v0[0] += bflo(xw.x); v0[1] += bfhi(xw.x); v0[2] += bflo(xw.y); v0[3] += bfhi(xw.y); v1[0] += bflo(xw.z); v1[1] += bfhi(xw.z); v1[2] += bflo(xw.w); v1[3] += bfhi(xw.w);
                    q += (v0[0] * v0[0] + v0[1] * v0[1]) + (v0[2] * v0[2] + v0[3] * v0[3]) + (v1[0] * v1[0] + v1[1] * v1[1]) + (v1[2] * v1[2] + v1[3] * v1[3]);
                    *(u32x4*)(x1 + off + bj * HALF) = pack8(v0, v1); }
                q += __shfl_xor(q, 16); q += __shfl_xor(q, 32);
                if (fq == 0) ss[(size_t)row * 16 + u.pn * 4 + wc] = q; }
    }
};
template <int CTRL> __device__ __forceinline__ float dpp_z(float src) { return __builtin_bit_cast(float, __builtin_amdgcn_update_dpp(0, __builtin_bit_cast(int, src), CTRL, 0xf, 0xf, true)); }
template <int CTRL> __device__ __forceinline__ float dpp_mov(float old, float src) { return __builtin_bit_cast(float, __builtin_amdgcn_update_dpp(__builtin_bit_cast(int, old), __builtin_bit_cast(int, src), CTRL, 0xf, 0xf, false)); }
struct EpiUpAct {
    static constexpr bool PERM = true, AFTER_DRAIN = false;
    bf16_t* act; const float* ss; const float* cw; const float* cb; const float* sconv; float* cp; float* uvs; float* ul; float* sconv_out; int mp; __amdgpu_buffer_rsrc_t wsr; unsigned o_act, o_cp, o_uvs, o_ul;
    const PG8_LAS float* rsl;
    __device__ __forceinline__ void operator()(const f32x4 (&acc)[2][2][4][2], const Unit& u, int wr, int wc, int fr, int fq) const {
        if (u.pm * BM >= mp) body<true>(acc, u, wr, wc, fr, fq); else body<false>(acc, u, wr, wc, fr, fq);
    }
    template <bool sample>
    __device__ __forceinline__ void body(const f32x4 (&acc)[2][2][4][2], const Unit& u, int wr, int wc, int fr, int fq) const {
        if constexpr (sample) body_sample(acc, u, wr, wc, fr, fq); else body_prompt(acc, u, wr, wc, fr, fq);
    }
    __device__ __forceinline__ void body_prompt(const f32x4 (&acc)[2][2][4][2], const Unit& u, int wr, int wc, int fr, int fq) const {
        typedef float f32x2 __attribute__((ext_vector_type(2)));
        const int col0 = u.pn * 128 + wc * 32 + 8 * fq;
        f32x2 W0[4], W1[4], W2[4], BB[4], W1m[4], W0m[4];
        { const f32x2* pa = (const f32x2*)(cw + col0); const f32x2* pb = (const f32x2*)(cw + 2816 + col0); const f32x2* pc = (const f32x2*)(cw + 2 * 2816 + col0); const f32x2* pd = (const f32x2*)(cb + col0);
          const f32x2 z2 = {0.f, 0.f};
#pragma unroll
          for (int q = 0; q < 4; ++q) { W0[q] = pa[q]; W1[q] = pb[q]; W2[q] = pc[q]; BB[q] = pd[q]; W1m[q] = (fr == 0) ? W1[q] : z2; W0m[q] = (fr < 2) ? W0[q] : z2; } }
        const f32x2 K1 = {-2.8853900817779268f * 0.035677408136300125f, -2.8853900817779268f * 0.035677408136300125f}, K0 = {-2.8853900817779268f * 0.7978845608028654f, -2.8853900817779268f * 0.7978845608028654f};
        const PG8_LAS float* rs = rsl + (-1 - u.kz) * 256;
#pragma unroll
        for (int ai = 0; ai < 2; ++ai) { const int rb = u.pm * BM + ai * HALF + wr * 64, blk = rb >> 6;
            f32x2 XM[4];
#pragma unroll
            for (int m = 0; m < 4; ++m) { const int row = rb + 16 * m + fr; const float s = rs[row & 255];
                f32x2 X[4], U[4], C[4], O[4];
#pragma unroll
                for (int q = 0; q < 4; ++q) { const f32x4 av = acc[ai][0][m][q >> 1], uv4 = acc[ai][1][m][q >> 1];
                    X[q] = (f32x2){av[2 * (q & 1)], av[2 * (q & 1) + 1]} * s; U[q] = (f32x2){uv4[2 * (q & 1)], uv4[2 * (q & 1) + 1]} * s; }
#pragma unroll
                for (int q = 0; q < 4; ++q) {
                    f32x2 c = __builtin_elementwise_fma(W2[q], X[q], BB[q]);
                    c = __builtin_elementwise_fma((f32x2){dpp_z<0x111>(X[q][0]), dpp_z<0x111>(X[q][1])}, W1[q], c);
                    c = __builtin_elementwise_fma((f32x2){dpp_z<0x112>(X[q][0]), dpp_z<0x112>(X[q][1])}, W0[q], c);
                    if (m > 0) { c = __builtin_elementwise_fma((f32x2){dpp_z<0x121>(XM[q][0]), dpp_z<0x121>(XM[q][1])}, W1m[q], c);
                                 c = __builtin_elementwise_fma((f32x2){dpp_z<0x122>(XM[q][0]), dpp_z<0x122>(XM[q][1])}, W0m[q], c); }
                    C[q] = c;
                    const f32x2 nz = c * __builtin_elementwise_fma(c * c, K1, K0);
                    const f32x2 den = (f32x2){__builtin_amdgcn_exp2f(nz[0]), __builtin_amdgcn_exp2f(nz[1])} + 1.0f;
                    O[q] = (c * U[q]) * (f32x2){__builtin_amdgcn_rcpf(den[0]), __builtin_amdgcn_rcpf(den[1])}; XM[q] = X[q]; }
                { const f32x4 oa = {O[0][0], O[0][1], O[1][0], O[1][1]}, ob = {O[2][0], O[2][1], O[3][0], O[3][1]};
                  st_wt(wsr, o_act + (unsigned)(((size_t)row * 2816 + col0) * 2), pack8(oa, ob)); }
                if (m == 0 && fr < 2) { const unsigned so = (unsigned)((((size_t)blk * 2 + fr) * 2816 + col0) * 4);
                    st_wt(wsr, o_cp + so, (f32x4){C[0][0], C[0][1], C[1][0], C[1][1]}); st_wt(wsr, o_cp + so + 16, (f32x4){C[2][0], C[2][1], C[3][0], C[3][1]});
                    st_wt(wsr, o_uvs + so, (f32x4){U[0][0], U[0][1], U[1][0], U[1][1]}); st_wt(wsr, o_uvs + so + 16, (f32x4){U[2][0], U[2][1], U[3][0], U[3][1]}); }
                if (m == 3 && fr >= 14) { const unsigned so = (unsigned)((((size_t)blk * 2 + (fr - 14)) * 2816 + col0) * 4);
                    st_wt(wsr, o_ul + so, (f32x4){X[0][0], X[0][1], X[1][0], X[1][1]}); st_wt(wsr, o_ul + so + 16, (f32x4){X[2][0], X[2][1], X[3][0], X[3][1]}); } } }
    }
    __device__ __forceinline__ void body_sample(const f32x4 (&acc)[2][2][4][2], const Unit& u, int wr, int wc, int fr, int fq) const {
        constexpr bool sample = true;
        const int col0 = u.pn * 128 + wc * 32 + 8 * fq;
        float w0[8], w1[8], w2[8], bb[8];
        { const f32x4 a0 = *(const f32x4*)(cw + col0), a1 = *(const f32x4*)(cw + col0 + 4), b0 = *(const f32x4*)(cw + 2816 + col0), b1 = *(const f32x4*)(cw + 2816 + col0 + 4);
          const f32x4 c0 = *(const f32x4*)(cw + 2 * 2816 + col0), c1 = *(const f32x4*)(cw + 2 * 2816 + col0 + 4), d0 = *(const f32x4*)(cb + col0), d1 = *(const f32x4*)(cb + col0 + 4);
#pragma unroll
          for (int e = 0; e < 4; ++e) { w0[e] = a0[e]; w0[4 + e] = a1[e]; w1[e] = b0[e]; w1[4 + e] = b1[e]; w2[e] = c0[e]; w2[4 + e] = c1[e]; bb[e] = d0[e]; bb[4 + e] = d1[e]; } }
        float w1m[8], w0m[8];
#pragma unroll
        for (int e = 0; e < 8; ++e) { w1m[e] = (fr == 0) ? w1[e] : 0.f; w0m[e] = (fr < 2) ? w0[e] : 0.f; }
#pragma unroll
        for (int ai = 0; ai < 2; ++ai) { const int rb = u.pm * BM + ai * HALF + wr * 64, blk = rb >> 6;
            float xm1[8];
#pragma unroll
            for (int e = 0; e < 8; ++e) xm1[e] = 0.f;
#pragma unroll
            for (int m = 0; m < 4; ++m) { const int row = rb + 16 * m + fr; float s;
                if (sample) { const f32x4* sp = (const f32x4*)(ss + (size_t)row * 16);
                    const f32x4 s0 = sp[0], s1 = sp[1], s2 = sp[2], s3 = sp[3]; const f32x4 st = (s0 + s1) + (s2 + s3);
                    s = __builtin_amdgcn_rsqf(((st[0] + st[1]) + (st[2] + st[3])) * (1.0f / 1024.0f) + 1e-6f); }
                else s = rsl[(-1 - u.kz) * 256 + (row & 255)];
                float x[8], uvv[8], p1[8], p2[8], c8[8], o8[8];
#pragma unroll
                for (int e = 0; e < 4; ++e) { x[e] = acc[ai][0][m][0][e] * s; x[4 + e] = acc[ai][0][m][1][e] * s; uvv[e] = acc[ai][1][m][0][e] * s; uvv[4 + e] = acc[ai][1][m][1][e] * s; }
                if constexpr (sample) {
#pragma unroll
                for (int e = 0; e < 8; ++e) { const float t1 = dpp_mov<0x121>(0.f, xm1[e]), t2 = dpp_mov<0x122>(0.f, xm1[e]);
                    p1[e] = dpp_mov<0x111>(t1, x[e]); p2[e] = dpp_mov<0x112>(t2, x[e]); }
                }
                if (sample) { const int t = fr & 7;
                    if (t < 2) { const float* sc = sconv + (size_t)((row - mp) >> 3) * 2 * 2816 + col0;
#pragma unroll
                        for (int e = 0; e < 8; ++e) { const float c1v = sc[2816 + e]; if (t == 0) { p2[e] = sc[e]; p1[e] = c1v; } else p2[e] = c1v; } }
                    if (t >= 6) { float* so = sconv_out + ((size_t)((row - mp) >> 3) * 2 + (t - 6)) * 2816 + col0; *(f32x4*)so = (f32x4){x[0], x[1], x[2], x[3]}; *(f32x4*)(so + 4) = (f32x4){x[4], x[5], x[6], x[7]}; } }
#pragma unroll
                for (int e = 0; e < 8; ++e) { float c;
                    if constexpr (sample) c = __builtin_fmaf(w2[e], x[e], __builtin_fmaf(w1[e], p1[e], __builtin_fmaf(w0[e], p2[e], bb[e])));
                    else { c = __builtin_fmaf(w2[e], x[e], bb[e]); c = __builtin_fmaf(dpp_z<0x111>(x[e]), w1[e], c); c = __builtin_fmaf(dpp_z<0x112>(x[e]), w0[e], c);
                        if (m > 0) { c = __builtin_fmaf(dpp_z<0x121>(xm1[e]), w1m[e], c); c = __builtin_fmaf(dpp_z<0x122>(xm1[e]), w0m[e], c); } }
                    c8[e] = c;
                    const float nz = c * __builtin_fmaf(c * c, -2.8853900817779268f * 0.035677408136300125f, -2.8853900817779268f * 0.7978845608028654f);
                    o8[e] = (c * uvv[e]) * __builtin_amdgcn_rcpf(1.0f + __builtin_amdgcn_exp2f(nz)); xm1[e] = x[e]; }
                f32x4 oa = {o8[0], o8[1], o8[2], o8[3]}, ob = {o8[4], o8[5], o8[6], o8[7]};
                *(u32x4*)(act + (size_t)row * 2816 + col0) = pack8(oa, ob);
                if (!sample) {
                    if (m == 0 && fr < 2) { float* cpp = cp + ((size_t)blk * 2 + fr) * 2816 + col0; float* uvp = uvs + ((size_t)blk * 2 + fr) * 2816 + col0;
                        *(f32x4*)cpp = (f32x4){c8[0], c8[1], c8[2], c8[3]}; *(f32x4*)(cpp + 4) = (f32x4){c8[4], c8[5], c8[6], c8[7]};
                        *(f32x4*)uvp = (f32x4){uvv[0], uvv[1], uvv[2], uvv[3]}; *(f32x4*)(uvp + 4) = (f32x4){uvv[4], uvv[5], uvv[6], uvv[7]}; }
                    if (m == 3 && fr >= 14) { float* ulp = ul + ((size_t)blk * 2 + (fr - 14)) * 2816 + col0;
                        *(f32x4*)ulp = (f32x4){x[0], x[1], x[2], x[3]}; *(f32x4*)(ulp + 4) = (f32x4){x[4], x[5], x[6], x[7]}; } } } }
    }
};
struct EpiDown {
    static constexpr bool PERM = true, AFTER_DRAIN = false;
    bf16_t* x1; float* ss; float* slab; int tail_row0;
    __device__ __forceinline__ void operator()(const f32x4 (&acc)[2][2][4][2], const Unit& u, int wr, int wc, int fr, int fq) const {
        const int row0 = u.pm * BM + wr * 64 + fr, col0 = u.pn * BM + wc * 32 + 8 * fq;
        if (u.kz >= 0) { float* sl = slab + ((size_t)u.kz * 1024 - tail_row0) * 1024;
#pragma unroll
            for (int ai = 0; ai < 2; ++ai)
#pragma unroll
                for (int m = 0; m < 4; ++m) { float* rp = sl + (size_t)(row0 + ai * HALF + m * 16) * 1024 + col0;
#pragma unroll
                    for (int bj = 0; bj < 2; ++bj) { *(f32x4*)(rp + bj * HALF) = acc[ai][bj][m][0]; *(f32x4*)(rp + bj * HALF + 4) = acc[ai][bj][m][1]; } }
            return; }
#pragma unroll
        for (int ai = 0; ai < 2; ++ai)
#pragma unroll
            for (int m = 0; m < 4; ++m) { const int row = row0 + ai * HALF + m * 16; const size_t off = (size_t)row * 1024 + col0; float q = 0.f;
#pragma unroll
                for (int bj = 0; bj < 2; ++bj) { const u32x4 b = *(const u32x4*)(x1 + off + bj * HALF);
                    f32x4 v0 = acc[ai][bj][m][0], v1 = acc[ai][bj][m][1];
                    v0[0] += bflo(b.x); v0[1] += bfhi(b.x); v0[2] += bflo(b.y); v0[3] += bfhi(b.y); v1[0] += bflo(b.z); v1[1] += bfhi(b.z); v1[2] += bflo(b.w); v1[3] += bfhi(b.w);
                    q += (v0[0] * v0[0] + v0[1] * v0[1]) + (v0[2] * v0[2] + v0[3] * v0[3]) + (v1[0] * v1[0] + v1[1] * v1[1]) + (v1[2] * v1[2] + v1[3] * v1[3]);
                    *(u32x4*)(x1 + off + bj * HALF) = pack8(v0, v1); }
                q += __shfl_xor(q, 16); q += __shfl_xor(q, 32);
                if (fq == 0) __hip_atomic_store(ss + (size_t)row * 16 + u.pn * 4 + wc, q, __ATOMIC_RELAXED, __HIP_MEMORY_SCOPE_AGENT); }
    }
};

template <class Epi, class Sched, bool ALIGN_EPI = false, bool SP2 = false>
__device__ __forceinline__ void gemm_phase(PG8_LAS unsigned char* lds, const Gemm g, const Sched& S, const Epi& E) {
    int tid_ = threadIdx.x; asm volatile("" : "+v"(tid_));
    const int tid = tid_, wid = __builtin_amdgcn_readfirstlane(tid >> 6), lane = tid & 63, wr = wid >> 2, wc = wid & 3, fr = lane & 15, fq = lane >> 4;
    const int K = g.K;
    unsigned voffA[2], voffB[2];
#pragma unroll
    for (int i = 0; i < 2; ++i) { int R, C; stage_rc(tid * 16 + i * 8192, R, C); const int Rb = Epi::PERM ? ((R & ~31) + perm32(R & 31)) : R;
        voffA[i] = (unsigned)(R * g.lda + C) * 2u; voffB[i] = (unsigned)(Rb * g.ldb + C) * 2u; }
    const size_t kstep = (size_t)(BK * 2);
    const size_t hstepA = (size_t)HALF * g.lda * 2, hstepB = (size_t)g.bhalf_rows * g.ldb * 2;
    const size_t tstepA = (size_t)BM * g.lda * 2, tstepB = (size_t)g.btile_rows * g.ldb * 2;
    const unsigned ldsw = (unsigned)wid * 1024u;
    const int aoff = lds_byte(wr * 64 + fr, fq * 8), boff = lds_byte(wc * 32 + fr, fq * 8);
#define PG8_SA(b, h) (((b) * 2 + (h)) * HTB)
#define PG8_SB(b, h) ((4 + (b) * 2 + (h)) * HTB)
#define PG8_STAGE(bufoff, gbase, voff) do { _Pragma("unroll") for (int _i = 0; _i < 2; ++_i) \
        __builtin_amdgcn_global_load_lds((const unsigned*)((const char*)(gbase) + (voff)[_i]), (PG8_LAS unsigned*)(lds + (bufoff) + ldsw + _i * 8192), 16, 0, 0); } while (0)
#define PG8_LDA(dst, b, h) do { _Pragma("unroll") for (int m = 0; m < 4; ++m) _Pragma("unroll") for (int k = 0; k < 2; ++k) dst[m][k] = *(const PG8_LAS bf16x8*)(lds + PG8_SA(b, h) + aoff + m * 2048 + k * 1024); } while (0)
#define PG8_LDB(dst, b, h) do { _Pragma("unroll") for (int n = 0; n < 2; ++n) _Pragma("unroll") for (int k = 0; k < 2; ++k) dst[n][k] = *(const PG8_LAS bf16x8*)(lds + PG8_SB(b, h) + boff + n * 2048 + k * 1024); } while (0)
#define PG8_MMA(ai, bj, At, Bt) do { __builtin_amdgcn_s_setprio(1); _Pragma("unroll") for (int m = 0; m < 4; ++m) _Pragma("unroll") for (int n = 0; n < 2; ++n) _Pragma("unroll") for (int k = 0; k < 2; ++k) \
        acc[ai][bj][m][n] = __builtin_amdgcn_mfma_f32_16x16x32_bf16(Bt[n][k], At[m][k], acc[ai][bj][m][n], 0, 0, 0); __builtin_amdgcn_s_setprio(0); } while (0)
#define PG8_WAIT_V(n) asm volatile("s_waitcnt vmcnt(" #n ")" ::: "memory")
#define PG8_WAIT_L(n) asm volatile("s_waitcnt lgkmcnt(" #n ")" ::: "memory")
#define PG8_BAR __builtin_amdgcn_s_barrier()
#define PG8_SCHED __builtin_amdgcn_sched_barrier(0)
    Unit cur, nxt; int ui = 0;
    if (!S.next(0, cur)) return;
    f32x4 acc[2][2][4][2];
#pragma unroll
    for (int a = 0; a < 2; ++a)
#pragma unroll
        for (int b = 0; b < 2; ++b)
#pragma unroll
            for (int m = 0; m < 4; ++m)
#pragma unroll
                for (int n = 0; n < 2; ++n) acc[a][b][m][n] = (f32x4){0.f, 0.f, 0.f, 0.f};
    bf16x8 At[4][2], B0[2][2], B1[2][2];
#define PG8_UA(u) ((const char*)g.A + (size_t)(u).pm * tstepA + ((u).kz > 0 ? (size_t)(u).kz * g.ksplit * 2 : 0))
#define PG8_UB(u) ((const char*)g.Bt + (size_t)(u).pn * tstepB + ((u).kz > 0 ? (size_t)(u).kz * g.ksplit * 2 : 0))
    const char* cA = PG8_UA(cur); const char* cB = PG8_UB(cur);
    S.a_ready(cur);
    if constexpr (SP2) {
        PG8_STAGE(PG8_SB(0, 0), cB, voffB); PG8_STAGE(PG8_SB(0, 1), cB + hstepB, voffB); PG8_STAGE(PG8_SA(0, 0), cA, voffA); PG8_STAGE(PG8_SA(0, 1), cA + hstepA, voffA);
        if (wr == 1) PG8_BAR;
        PG8_WAIT_V(2); PG8_BAR;
        PG8_STAGE(PG8_SB(1, 0), cB + kstep, voffB); PG8_STAGE(PG8_SA(1, 0), cA + kstep, voffA); PG8_STAGE(PG8_SB(1, 1), cB + hstepB + kstep, voffB);
        PG8_WAIT_V(6); PG8_BAR;
    } else {
        PG8_STAGE(PG8_SB(0, 0), cB, voffB); PG8_STAGE(PG8_SA(0, 0), cA, voffA); PG8_STAGE(PG8_SB(0, 1), cB + hstepB, voffB); PG8_STAGE(PG8_SA(0, 1), cA + hstepA, voffA);
        if (wr == 1) PG8_BAR;
        PG8_WAIT_V(4); PG8_BAR;
        PG8_STAGE(PG8_SB(1, 0), cB + kstep, voffB); PG8_STAGE(PG8_SA(1, 0), cA + kstep, voffA); PG8_STAGE(PG8_SB(1, 1), cB + hstepB + kstep, voffB);
        PG8_WAIT_V(6); PG8_BAR;
    }
    for (;;) {
        const bool has_next = S.next(ui + 1, nxt);
        const char* nA = has_next ? PG8_UA(nxt) : cA; const char* nB = has_next ? PG8_UB(nxt) : cB;
        const int nt = ((cur.kz >= 0) ? g.ksplit : K) / BK;
        for (int t = 0; t < nt; t += 2) {
            const bool last = (t == nt - 2);
            const char* a1 = cA + (size_t)(t + 1) * kstep;
            const char* a2 = last ? nA : cA + (size_t)(t + 2) * kstep; const char* b2 = last ? nB : cB + (size_t)(t + 2) * kstep;
            const char* a3 = a2 + kstep; const char* b3 = b2 + kstep;
            if (last && has_next) S.a_ready(nxt);
            if constexpr (SP2) {
            PG8_LDB(B0, 0, 0); PG8_LDB(B1, 0, 1); PG8_SCHED; PG8_LDA(At, 0, 0); PG8_STAGE(PG8_SA(1, 1), a1 + hstepA, voffA);
            PG8_WAIT_V(8); PG8_WAIT_L(0); PG8_BAR; PG8_MMA(0, 0, At, B0); PG8_MMA(0, 1, At, B1); PG8_BAR; PG8_SCHED;
            PG8_LDA(At, 0, 1); PG8_STAGE(PG8_SB(0, 0), b2, voffB); PG8_STAGE(PG8_SB(0, 1), b2 + hstepB, voffB); PG8_STAGE(PG8_SA(0, 0), a2, voffA);
            PG8_WAIT_V(8); PG8_WAIT_L(0); PG8_BAR; PG8_MMA(1, 0, At, B0); PG8_MMA(1, 1, At, B1); PG8_BAR; PG8_SCHED;
            PG8_LDB(B0, 1, 0); PG8_LDB(B1, 1, 1); PG8_SCHED; PG8_LDA(At, 1, 0); PG8_STAGE(PG8_SA(0, 1), a2 + hstepA, voffA);
            PG8_WAIT_V(8); PG8_WAIT_L(0); PG8_BAR; PG8_MMA(0, 0, At, B0); PG8_MMA(0, 1, At, B1); PG8_BAR; PG8_SCHED;
            PG8_LDA(At, 1, 1); PG8_STAGE(PG8_SB(1, 0), b3, voffB); PG8_STAGE(PG8_SB(1, 1), b3 + hstepB, voffB); PG8_STAGE(PG8_SA(1, 0), a3, voffA);
            PG8_WAIT_V(8); PG8_WAIT_L(0); PG8_BAR; PG8_MMA(1, 0, At, B0); PG8_MMA(1, 1, At, B1); PG8_BAR; PG8_SCHED;
            } else {
            PG8_LDB(B0, 0, 0); PG8_SCHED; PG8_LDA(At, 0, 0); PG8_STAGE(PG8_SA(1, 1), a1 + hstepA, voffA);
            PG8_WAIT_L(8); PG8_BAR; PG8_WAIT_L(0); PG8_MMA(0, 0, At, B0); PG8_BAR; PG8_SCHED;
            PG8_LDB(B1, 0, 1); PG8_STAGE(PG8_SB(0, 0), b2, voffB);
            PG8_BAR; PG8_WAIT_L(0); PG8_MMA(0, 1, At, B1); PG8_BAR;
            PG8_LDA(At, 0, 1); PG8_STAGE(PG8_SA(0, 0), a2, voffA);
            PG8_BAR; PG8_WAIT_L(0); PG8_MMA(1, 0, At, B0); PG8_BAR; PG8_SCHED;
            PG8_STAGE(PG8_SB(0, 1), b2 + hstepB, voffB);
            PG8_WAIT_V(6); PG8_BAR; PG8_MMA(1, 1, At, B1); PG8_BAR;
            PG8_LDB(B0, 1, 0); PG8_SCHED; PG8_LDA(At, 1, 0); PG8_STAGE(PG8_SA(0, 1), a2 + hstepA, voffA);
            PG8_WAIT_L(8); PG8_BAR; PG8_WAIT_L(0); PG8_MMA(0, 0, At, B0); PG8_BAR; PG8_SCHED;
            PG8_LDB(B1, 1, 1); PG8_STAGE(PG8_SB(1, 0), b3, voffB);
            PG8_BAR; PG8_WAIT_L(0); PG8_MMA(0, 1, At, B1); PG8_BAR;
            PG8_LDA(At, 1, 1); PG8_STAGE(PG8_SA(1, 0), a3, voffA);
            PG8_BAR; PG8_WAIT_L(0); PG8_MMA(1, 0, At, B0); PG8_BAR; PG8_SCHED;
            PG8_STAGE(PG8_SB(1, 1), b3 + hstepB, voffB);
            PG8_WAIT_V(6); PG8_BAR; PG8_MMA(1, 1, At, B1); PG8_BAR;
            }
        }
        if constexpr (ALIGN_EPI) { if (wr == 0) PG8_BAR; }
        if constexpr (!Epi::AFTER_DRAIN) { E(acc, cur, wr, wc, fr, fq); S.done(cur); }
        if (!has_next) break;
#pragma unroll
        for (int a = 0; a < 2; ++a)
#pragma unroll
            for (int b = 0; b < 2; ++b)
#pragma unroll
                for (int m = 0; m < 4; ++m)
#pragma unroll
                    for (int n = 0; n < 2; ++n) acc[a][b][m][n] = (f32x4){0.f, 0.f, 0.f, 0.f};
        cur = nxt; cA = nA; cB = nB; ++ui;
        if constexpr (ALIGN_EPI) { if (wr == 1) PG8_BAR; }
    }
    PG8_WAIT_V(0);
    if constexpr (!ALIGN_EPI) { if (wr == 0) PG8_BAR; }
    PG8_BAR;
    if constexpr (Epi::AFTER_DRAIN) { E.fused(acc, cur, wr, wc, fr, fq, lds, wid, lane); S.done(cur); }
#undef PG8_UA
#undef PG8_UB
#undef PG8_SA
#undef PG8_SB
#undef PG8_STAGE
#undef PG8_LDA
#undef PG8_LDB
#undef PG8_MMA
#undef PG8_WAIT_V
#undef PG8_WAIT_L
#undef PG8_BAR
#undef PG8_SCHED
}
}

#define GAS __attribute__((address_space(1)))
#define LAS __attribute__((address_space(3)))
typedef unsigned short bf16;
typedef unsigned v4u __attribute__((ext_vector_type(4)));
typedef float f32x4 __attribute__((ext_vector_type(4)));
typedef short bf16x8 __attribute__((ext_vector_type(8)));
typedef GAS unsigned gu32;
typedef GAS unsigned long long gu64;
#define RLX_AGENT __ATOMIC_RELAXED, __HIP_MEMORY_SCOPE_AGENT
#define LDS_WAIT() asm volatile("s_waitcnt lgkmcnt(0)" ::: "memory")
#define VM_WAIT() asm volatile("s_waitcnt vmcnt(0)" ::: "memory")
__device__ __forceinline__ unsigned long long rt() { return __builtin_amdgcn_s_memrealtime(); }
__device__ __forceinline__ unsigned f2bf(float f) { unsigned u = __builtin_bit_cast(unsigned, f); return (u + 0x7fffu + ((u >> 16) & 1u)) >> 16; }
__device__ __forceinline__ unsigned pk2(float lo, float hi) { return f2bf(lo) | (f2bf(hi) << 16); }

#define XB_TMO      128
#define XB_XCNT(j)  (256  + 64 * (j))
#define XB_XSUB(j)  (1280 + 64 * (j))
#define XB_XGEN(j)  (2304 + 64 * (j))
#define XB_TOP      3328
#define XB_TOPGEN   3392
#define XCD_BAR_WORDS 3456
#define XB_SPIN_CAP (1u << 18)

__device__ __forceinline__ unsigned xb_ld(unsigned* p)              { return __hip_atomic_load(p, __ATOMIC_RELAXED, __HIP_MEMORY_SCOPE_AGENT); }
__device__ __forceinline__ unsigned xb_add(unsigned* p, unsigned v) { return __hip_atomic_fetch_add(p, v, __ATOMIC_RELAXED, __HIP_MEMORY_SCOPE_AGENT); }
__device__ __forceinline__ unsigned xb_xcc_id() { return (unsigned)__builtin_amdgcn_s_getreg((3 << 11) | 20) & 0xFu; }
#define XB_SPIN(cond, bar) do { unsigned _sp = 0; while (cond) { __builtin_amdgcn_s_sleep(1); \
    if ((++_sp & 255u) == 0u) { if (xb_ld(&(bar)[XB_TMO])) break; if (_sp > XB_SPIN_CAP) { atomicAdd(&(bar)[XB_TMO], 1u); break; } } } } while (0)

struct XcdBarrier {
    unsigned* bar; unsigned x;
    volatile LAS unsigned* st;
};

__device__ __forceinline__ XcdBarrier xcd_barrier_post(unsigned* bar, volatile LAS unsigned* st) {
    XcdBarrier b; b.bar = bar; b.x = xb_xcc_id(); b.st = st;
    if (threadIdx.x == 0) (void)xb_add(&bar[XB_XCNT(b.x)], 1u);
    return b;
}
__device__ __forceinline__ void xcd_barrier_complete(unsigned* bar, unsigned x, unsigned& nloc, unsigned& nx) {
    const unsigned G = gridDim.x * gridDim.y * gridDim.z;
    unsigned sum, cnt, mine, sp = 0u;
    for (;;) {
        sum = 0u; cnt = 0u; mine = 0u;
#pragma unroll
        for (unsigned j = 0; j < 16; ++j) { const unsigned c = xb_ld(&bar[XB_XCNT(j)]); sum += c; cnt += (c > 0u) ? 1u : 0u; mine = (j == x) ? c : mine; }
        if (sum == G) break;
        __builtin_amdgcn_s_sleep(1);
        if ((++sp & 255u) == 0u) { if (xb_ld(&bar[XB_TMO])) break; if (sp > XB_SPIN_CAP) { atomicAdd(&bar[XB_TMO], 1u); break; } }
    }
    nloc = mine > 0u ? mine : 1u; nx = cnt > 0u ? cnt : 1u;
}

__device__ __forceinline__ void xcd_barrier(const XcdBarrier& b) {
    asm volatile("s_waitcnt vmcnt(0)" ::: "memory");
    __syncthreads();
    if (threadIdx.x == 0) {
        unsigned* bar = b.bar;
        __builtin_amdgcn_s_waitcnt(0);
        unsigned nloc = b.st[0], nx = b.st[1];
        if (nloc == 0u) { xcd_barrier_complete(bar, b.x, nloc, nx); b.st[0] = nloc; b.st[1] = nx; }
        const unsigned old = xb_add(&bar[XB_XSUB(b.x)], 1u);
        const unsigned gen = old / nloc;
        if (old + 1u == (gen + 1u) * nloc) {
            __builtin_amdgcn_fence(__ATOMIC_RELEASE, "agent");
            asm volatile("s_waitcnt vmcnt(0)" ::: "memory");
            const unsigned og = xb_add(&bar[XB_TOP], 1u);
            const unsigned tg = og / nx;
            if (og + 1u == (tg + 1u) * nx) xb_add(&bar[XB_TOPGEN], 1u);
            else XB_SPIN(xb_ld(&bar[XB_TOPGEN]) == tg, bar);
            __builtin_amdgcn_fence(__ATOMIC_ACQUIRE, "agent");
            xb_add(&bar[XB_XGEN(b.x)], 1u);
            asm volatile("s_waitcnt vmcnt(0)" ::: "memory");
        } else {
            XB_SPIN(xb_ld(&bar[XB_XGEN(b.x)]) == gen, bar);
            __builtin_amdgcn_fence(__ATOMIC_ACQUIRE, "agent");
            asm volatile("s_waitcnt vmcnt(0)" ::: "memory");
        }
    }
    __syncthreads();
}


constexpr int NWAVES = 8;
constexpr int DM = 1024, SEQ = 2048, NB = 16, DECB = 128, DECT = 8;
constexpr int MP = NB * SEQ, MS = DECB * DECT, M = MP + MS;
constexpr int QKVW = 768, RWS = 1792, INC = 4608, DFF = 2816, RW = 512;
constexpr int PAST = 16384;
#ifndef PROBE_SKIP
#define PROBE_SKIP 0
#endif
#ifndef PROBE_DUP
#define PROBE_DUP -1
#endif
#ifndef MK_N_LAUNCHES
#define MK_N_LAUNCHES 1
#endif
constexpr int NPH = 10;
constexpr int N_LAUNCHES = MK_N_LAUNCHES;

constexpr size_t MiB = 1u << 20;
constexpr size_t WS_CTL = 0, CTL_ZERO_BYTES = 1 * MiB;
constexpr size_t WS_WIN = 2 * MiB, WS_WPA = 11 * MiB, WS_WPB = 12 * MiB, WS_WO = 13 * MiB, WS_WUP = 15 * MiB, WS_WDN = 26 * MiB;
constexpr size_t WS_W2T = 39 * MiB, WS_A2T = WS_W2T + 65536, WS_G2T = WS_A2T + 65536;
constexpr size_t WS_RS1 = 32 * MiB, WS_SS2 = 33 * MiB, WS_SS3 = 36 * MiB;
constexpr size_t WS_BUFA = 40 * MiB;
constexpr size_t WS_QKV = 106 * MiB;
constexpr size_t WS_RWB = 156 * MiB;
constexpr size_t WS_GA = 272 * MiB;
constexpr size_t WS_GB = 338 * MiB;
constexpr size_t WS_GA8 = 371 * MiB;
constexpr size_t WS_ATT = 404 * MiB;
constexpr size_t WS_RWO = 437 * MiB;
constexpr size_t WS_ASIG = 470 * MiB;
constexpr size_t WS_UG = 330 * MiB;
constexpr size_t WS_UV = 142 * MiB;
constexpr size_t WS_CP = 106 * MiB, WS_UVS = 118 * MiB, WS_UL = 130 * MiB;
constexpr size_t WS_MIXS = 504 * MiB;
constexpr size_t WS_END = 507 * MiB;
constexpr int CW_TMO = 0, CW_CODE = 1, CW_SUB = 2048, CW_BAR = 4096, CW_DF = 8192;
constexpr size_t O_Y = 0, O_PWK = 34603008, O_PWV = 34865152, O_PSH = 35127296, O_PWKV = 35155968, O_PCONV = 35680256,
                 O_SWK = 35770368, O_SWV = 37867520, O_SSH = 39964672, O_SWKV = 40194048, O_SCONV = 44388352;
constexpr int RING_OFF = 0, RING_BYTES = 131072;
constexpr int LDSCTL_OFF = 162816, MISC_OFF = LDSCTL_OFF + 320;
constexpr int LDS_BYTES = 163840;

__device__ const unsigned char T5_BUCKET[128] = {0, 1, 2, 3, 4, 5, 6, 7, 8, 9, 10, 11, 12, 13, 14, 15, 16, 16, 16, 17, 17, 18, 18, 18, 19, 19, 19, 20, 20, 20, 20, 21, 21, 21, 21, 22, 22, 22, 22, 22, 23, 23, 23, 23, 23, 23, 24, 24, 24, 24, 24, 24, 25, 25, 25, 25, 25, 25, 25, 26, 26, 26, 26, 26, 26, 26, 26, 27, 27, 27, 27, 27, 27, 27, 27, 27, 27, 28, 28, 28, 28, 28, 28, 28, 28, 28, 28, 29, 29, 29, 29, 29, 29, 29, 29, 29, 29, 29, 29, 30, 30, 30, 30, 30, 30, 30, 30, 30, 30, 30, 30, 30, 30, 31, 31, 31, 31, 31, 31, 31, 31, 31, 31, 31, 31, 31, 31, 31};

struct Frame {
    LAS unsigned char* lds;
    volatile LAS unsigned* MISC;
    gu32* ctl;
    int tid, lane, wave;
    int vcu, G;
};
__device__ __forceinline__ float bf2f(bf16 h) { return __builtin_bit_cast(float, (unsigned)h << 16); }
__device__ __forceinline__ float bflo(unsigned w) { return __builtin_bit_cast(float, w << 16); }
__device__ __forceinline__ float bfhi(unsigned w) { return __builtin_bit_cast(float, w & 0xffff0000u); }
__device__ __forceinline__ float wave_sum(float v) {
    v += pg8::dpp_z<0xB1>(v); v += pg8::dpp_z<0x4E>(v); v += pg8::dpp_z<0x141>(v); v += pg8::dpp_z<0x140>(v);
    v += __shfl_xor(v, 16); v += __shfl_xor(v, 32);
    return v;
}
__device__ __forceinline__ float sigmoidf_(float x) { return 1.0f / (1.0f + __expf(-x)); }

struct Args { const float* in[31]; float* out; unsigned char* ws; int ph_lo, ph_hi, li, pad; };

__device__ __forceinline__ void p0_transpose_item(const float* W, const float* kscale, int K, int N, bf16* WT, LAS float* scr, int item, int lane) {
    const int nblk = N / 32, kb = item / nblk, nb = item % nblk, k0 = 64 * kb, n0 = 32 * nb;
    float wv[32];
#pragma unroll
    for (int i = 0; i < 32; ++i) wv[i] = W[(size_t)(k0 + 2 * i + (lane >> 5)) * N + n0 + (lane & 31)];
#pragma unroll
    for (int i = 0; i < 32; ++i) { const int kk = 2 * i + (lane >> 5); const float s = kscale ? kscale[k0 + kk] : 1.0f; scr[kk * 33 + (lane & 31)] = wv[i] * s; }
    LDS_WAIT(); asm volatile("" ::: "memory");
    const int c = lane & 7;
#pragma unroll
    for (int j = 0; j < 4; ++j) { const int n = (lane >> 3) + 8 * j; const LAS float* s = scr + (8 * c) * 33 + n;
        v4u o; o.x = pk2(s[0 * 33], s[1 * 33]); o.y = pk2(s[2 * 33], s[3 * 33]); o.z = pk2(s[4 * 33], s[5 * 33]); o.w = pk2(s[6 * 33], s[7 * 33]);
        *(GAS v4u*)(WT + (size_t)(n0 + n) * K + k0 + 8 * c) = o; }
    LDS_WAIT(); asm volatile("" ::: "memory");
}
__device__ __forceinline__ void p0_weights(Frame& F, const Args& a, int part, int gw, int NGW) {
    unsigned char* ws = a.ws;
    LAS float* scr = (LAS float*)(F.lds + RING_OFF + F.wave * 16384);
    constexpr int I_IN = (DM / 64) * (INC / 32), I_PA = (RW / 64) * (DM / 32), I_O = (DM / 64) * (DM / 32), I_UP = (DM / 64) * (2 * DFF / 32), I_DN = (DFF / 64) * (DM / 32);
    constexpr int I_L64 = (64 / 64) * (RW / 32), I_L128 = (128 / 64) * (RW / 32);
    if (part == 0) {
        constexpr int NITEMS = I_IN + I_PA + 2 * I_L64 + I_L128;
        for (int it = gw; it < NITEMS; it += NGW) { int r = it;
            if (r < I_IN) { p0_transpose_item(a.in[9], a.in[8], DM, INC, (bf16*)(ws + WS_WIN), scr, r, F.lane); continue; } r -= I_IN;
            if (r < I_PA) { p0_transpose_item(a.in[22], nullptr, RW, DM, (bf16*)(ws + WS_WPA), scr, r, F.lane); continue; } r -= I_PA;
            if (r < I_L64) { p0_transpose_item(a.in[13], nullptr, 64, RW, (bf16*)(ws + WS_W2T), scr, r, F.lane); continue; } r -= I_L64;
            if (r < I_L64) { p0_transpose_item(a.in[15], nullptr, 64, RW, (bf16*)(ws + WS_A2T), scr, r, F.lane); continue; } r -= I_L64;
            p0_transpose_item(a.in[16], nullptr, 128, RW, (bf16*)(ws + WS_G2T), scr, r, F.lane); }
    } else if (part == 1) {
        constexpr int NITEMS = I_PA + I_O;
        for (int it = gw; it < NITEMS; it += NGW) { int r = it;
            if (r < I_PA) { p0_transpose_item(a.in[23], nullptr, RW, DM, (bf16*)(ws + WS_WPB), scr, r, F.lane); continue; } r -= I_PA;
            p0_transpose_item(a.in[24], nullptr, DM, DM, (bf16*)(ws + WS_WO), scr, r, F.lane); }
    } else {
        constexpr int NITEMS = I_UP + I_DN;
        for (int it = gw; it < NITEMS; it += NGW) { int r = it;
            if (r < I_UP) { p0_transpose_item(a.in[26], a.in[25], DM, 2 * DFF, (bf16*)(ws + WS_WUP), scr, r, F.lane); continue; } r -= I_UP;
            p0_transpose_item(a.in[29], nullptr, DFF, DM, (bf16*)(ws + WS_WDN), scr, r, F.lane); }
    }
}
__device__ __forceinline__ void p0_prologue(Frame& F, const Args& a) {
    unsigned char* ws = a.ws;
    const int gw = F.vcu * NWAVES + F.wave, NGW = F.G * NWAVES;
    p0_weights(F, a, 0, gw, NGW);
    bf16* XB = (bf16*)(ws + WS_BUFA); float* RS1 = (float*)(ws + WS_RS1);
    for (int m0 = 4 * gw; m0 < M; m0 += 4 * NGW) {
        f32x4 v[4][4];
#pragma unroll
        for (int k = 0; k < 4; ++k) { const int m = m0 + k; const float* xrow = (m < MP) ? a.in[0] + (size_t)m * DM : a.in[1] + (size_t)(m - MP) * DM; const GAS f32x4* xr = (const GAS f32x4*)xrow + F.lane;
#pragma unroll
            for (int j = 0; j < 4; ++j) v[k][j] = __builtin_nontemporal_load(&xr[64 * j]); }
#pragma unroll
        for (int k = 0; k < 4; ++k) { const int m = m0 + k; float s_ = 0.f;
#pragma unroll
            for (int j = 0; j < 4; ++j) s_ += (v[k][j].x * v[k][j].x + v[k][j].y * v[k][j].y) + (v[k][j].z * v[k][j].z + v[k][j].w * v[k][j].w);
            s_ = wave_sum(s_);
            if (F.lane == 0) RS1[m] = 1.0f / sqrtf(s_ * (1.0f / DM) + 1e-6f);
            GAS unsigned long long* o8 = (GAS unsigned long long*)(XB + (size_t)m * DM) + F.lane;
#pragma unroll
            for (int j = 0; j < 4; ++j) o8[64 * j] = (unsigned long long)pk2(v[k][j].x, v[k][j].y) | ((unsigned long long)pk2(v[k][j].z, v[k][j].w) << 32); }
    }
}

constexpr int KPITCH = 72;
typedef float f32x16 __attribute__((ext_vector_type(16)));
typedef short v4i16_t __attribute__((ext_vector_type(4)));
typedef unsigned u32x2_t __attribute__((ext_vector_type(2)));
__device__ __forceinline__ v4i16_t lds_tr16(const LAS void* p) { return __builtin_amdgcn_ds_read_tr16_b64_v4i16((LAS v4i16_t*)p); }
typedef float f32x2_t __attribute__((ext_vector_type(2))); typedef __bf16 bf16x2_t __attribute__((ext_vector_type(2)));
__device__ __forceinline__ unsigned cvtpk(float lo, float hi) { f32x2_t v = {lo, hi}; bf16x2_t b = __builtin_convertvector(v, bf16x2_t); return __builtin_bit_cast(unsigned, b); }
constexpr float LOG2E = 1.4426950408889634f;
__device__ __forceinline__ void attn_block(const LAS bf16* Ks, const LAS bf16* Vs, const LAS float* biasM, const bf16x8 (&qf)[4], bf16* optr, int t0, int skip_lt, int ql, int gl, float sink2, int lane) {
    const int r32 = lane & 31, h = lane >> 5;
    f32x16 s[5];
    const LAS float* bt = biasM + gl * 192 + (160 + ql - 4 * h);
#pragma unroll
    for (int tt = 0; tt < 5; ++tt) {
        const int T = t0 + tt;
        if (T < skip_lt) {
#pragma unroll
            for (int r = 0; r < 16; ++r) s[tt][r] = -1e30f;
        } else {
            f32x16 acc;
#pragma unroll
            for (int r = 0; r < 16; ++r) acc[r] = bt[-(32 * tt + (r & 3) + 8 * (r >> 2))];
            const LAS bf16* kp = Ks + (32 * T + r32) * KPITCH + 8 * h;
#pragma unroll
            for (int k = 0; k < 4; ++k) { const bf16x8 kf = *(const LAS bf16x8*)(kp + 16 * k); acc = __builtin_amdgcn_mfma_f32_32x32x16_bf16(kf, qf[k], acc, 0, 0, 0); }
            s[tt] = acc;
        }
    }
    float m = sink2;
#pragma unroll
    for (int tt = 0; tt < 5; ++tt)
#pragma unroll
        for (int r = 0; r < 16; ++r) m = fmaxf(m, s[tt][r]);
    m = fmaxf(m, __shfl_xor(m, 32));
    float l = 0.f; constexpr float CS = 0.125f * LOG2E; const float mneg = -CS * m;
#pragma unroll
    for (int tt = 0; tt < 5; ++tt)
#pragma unroll
        for (int r = 0; r < 16; ++r) { const float p = __builtin_amdgcn_exp2f(__builtin_fmaf(s[tt][r], CS, mneg)); s[tt][r] = p; l += p; }
    l += __shfl_xor(l, 32); l += __builtin_amdgcn_exp2f(__builtin_fmaf(sink2, CS, mneg));
    f32x16 o[2];
#pragma unroll
    for (int r = 0; r < 16; ++r) { o[0][r] = 0.f; o[1][r] = 0.f; }
    const int q4 = (lane & 15) >> 2, p4 = lane & 3, dblk = (lane >> 4) & 1;
    const LAS char* vb = (const LAS char*)Vs + (4 * h + q4) * 64 + dblk * 32 + p4 * 8;
#pragma unroll
    for (int tt = 0; tt < 5; ++tt) {
        const int T = t0 + tt;
        if (T >= skip_lt) {
#pragma unroll
            for (int ks = 0; ks < 2; ++ks) {
                v4u pw; pw.x = cvtpk(s[tt][8 * ks + 0], s[tt][8 * ks + 1]); pw.y = cvtpk(s[tt][8 * ks + 2], s[tt][8 * ks + 3]);
                pw.z = cvtpk(s[tt][8 * ks + 4], s[tt][8 * ks + 5]); pw.w = cvtpk(s[tt][8 * ks + 6], s[tt][8 * ks + 7]);
                const bf16x8 pb = __builtin_bit_cast(bf16x8, pw);
#pragma unroll
                for (int dt = 0; dt < 2; ++dt) {
                    const v4i16_t lo = lds_tr16(vb + dt * 16384 + (32 * T + 16 * ks) * 64), hi = lds_tr16(vb + dt * 16384 + (32 * T + 16 * ks + 8) * 64);
                    const bf16x8 va = (bf16x8){lo[0], lo[1], lo[2], lo[3], hi[0], hi[1], hi[2], hi[3]};
                    o[dt] = __builtin_amdgcn_mfma_f32_32x32x16_bf16(va, pb, o[dt], 0, 0, 0);
                }
            }
        }
    }
    const float rl = __builtin_amdgcn_rcpf(l);
#pragma unroll
    for (int dt = 0; dt < 2; ++dt)
#pragma unroll
        for (int rq = 0; rq < 4; ++rq) { u32x2_t w; w.x = cvtpk(o[dt][4 * rq + 0] * rl, o[dt][4 * rq + 1] * rl); w.y = cvtpk(o[dt][4 * rq + 2] * rl, o[dt][4 * rq + 3] * rl);
            *(GAS u32x2_t*)(optr + 32 * dt + 8 * rq + 4 * h) = w; }
}
__device__ __forceinline__ void attn_v1(Frame& F, const Args& a, int u0, int ustride) {
    unsigned char* ws = a.ws;
    const bf16* QKV = (const bf16*)(ws + WS_QKV); bf16* ATT = (bf16*)(ws + WS_ATT);
    LAS bf16* Ks = (LAS bf16*)(F.lds); LAS bf16* Vs = (LAS bf16*)(F.lds + 256 * KPITCH * 2); LAS float* biasM = (LAS float*)(F.lds + 256 * KPITCH * 2 + 32768);
    const float* relb = a.in[7]; const float* sinks = a.in[10]; const float* cwk = a.in[2]; const float* cwv = a.in[3];
    const int tid = F.tid, lane = F.lane, wave = F.wave;
#define ATT_LOAD(u_, kr, vr) do { const bool pr_ = (u_) < 512; int b_, qb_, kv_; if (pr_) { b_ = (u_) >> 5; qb_ = ((u_) >> 1) & 15; kv_ = (u_) & 1; } else { b_ = ((u_) - 512) >> 1; qb_ = 0; kv_ = (u_) & 1; } \
        _Pragma("unroll") for (int i_ = 0; i_ < 4; ++i_) { const int c_ = tid + 512 * i_, li_ = c_ >> 3, ch_ = c_ & 7; v4u kvv = (v4u){0u, 0u, 0u, 0u}, vvv = kvv; \
            if (pr_) { const int pos_ = 128 * qb_ - 128 + li_; \
                if (pos_ >= 0) { const bf16* src = QKV + (size_t)(b_ * SEQ + pos_) * QKVW + 512 + kv_ * 64 + ch_ * 8; kvv = *(const GAS v4u*)src; vvv = *(const GAS v4u*)(src + 128); } \
            } else if (li_ < 128) { const float* sk = cwk + ((size_t)(b_ * 128 + li_) * 2 + kv_) * 64 + ch_ * 8; const float* sv = cwv + ((size_t)(b_ * 128 + li_) * 2 + kv_) * 64 + ch_ * 8; \
                const f32x4 k0_ = *(const GAS f32x4*)sk, k1_ = *(const GAS f32x4*)(sk + 4), v0_ = *(const GAS f32x4*)sv, v1_ = *(const GAS f32x4*)(sv + 4); \
                kvv.x = pk2(k0_[0], k0_[1]); kvv.y = pk2(k0_[2], k0_[3]); kvv.z = pk2(k1_[0], k1_[1]); kvv.w = pk2(k1_[2], k1_[3]); \
                vvv.x = pk2(v0_[0], v0_[1]); vvv.y = pk2(v0_[2], v0_[3]); vvv.z = pk2(v1_[0], v1_[1]); vvv.w = pk2(v1_[2], v1_[3]); \
            } else if (li_ < 128 + DECT) { const bf16* src = QKV + (size_t)(MP + b_ * DECT + li_ - 128) * QKVW + 512 + kv_ * 64 + ch_ * 8; kvv = *(const GAS v4u*)src; vvv = *(const GAS v4u*)(src + 128); } \
            kr[i_] = kvv; vr[i_] = vvv; } } while (0)
    v4u kreg[4], vreg[4];
    if (u0 < 768) ATT_LOAD(u0, kreg, vreg);
    for (int u = u0; u < 768; u += ustride) {
        const bool prompt = u < 512;
        int b, qb, kv; if (prompt) { b = u >> 5; qb = (u >> 1) & 15; kv = u & 1; } else { b = (u - 512) >> 1; qb = 0; kv = u & 1; }
        __syncthreads();
#pragma unroll
        for (int i = 0; i < 4; ++i) { const int c = tid + 512 * i, li = c >> 3, ch = c & 7;
            *(LAS v4u*)(Ks + li * KPITCH + ch * 8) = kreg[i]; *(LAS v4u*)(Vs + (ch >> 2) * 8192 + li * 32 + (ch & 3) * 8) = vreg[i]; }
        if (u + ustride < 768) ATT_LOAD(u + ustride, kreg, vreg);
        for (int idx = tid; idx < 768; idx += 512) { const int g = idx / 192, e = idx - g * 192, dist = e - 32;
            biasM[idx] = (dist >= 0 && dist < 128) ? relb[(int)T5_BUCKET[dist] * 8 + kv * 4 + g] * 8.0f : -1e30f; }
        bf16x8 qa[4]; int rowa, rowb, heada; float sinka;
        if (prompt) { const int g = wave >> 1; heada = kv * 4 + g; rowa = b * SEQ + qb * 128 + (wave & 1) * 64 + (lane & 31); rowb = rowa + 32; }
        else { const int i = lane & 7, g = (lane >> 3) & 3; heada = kv * 4 + g; rowa = MP + b * DECT + i; rowb = rowa; }
        sinka = sinks[heada] * 8.0f;
        const bf16* qp = QKV + (size_t)rowa * QKVW + heada * 64 + 8 * (lane >> 5); const bf16* qp2 = QKV + (size_t)rowb * QKVW + heada * 64 + 8 * (lane >> 5);
#pragma unroll
        for (int k = 0; k < 4; ++k) qa[k] = *(const GAS bf16x8*)(qp + 16 * k);
        __syncthreads();
        if (prompt) {
            const int g = wave >> 1, q0 = (wave & 1) * 64;
#pragma unroll 1
            for (int blk = 0; blk < 2; ++blk) {
                attn_block(Ks, Vs, biasM, qa, ATT + (size_t)(rowa + 32 * blk) * RW + heada * 64, (q0 + 32 * blk) >> 5, (qb == 0) ? 4 : 0, lane & 31, g, sinka, lane);
                if (blk == 0) {
#pragma unroll
                    for (int k = 0; k < 4; ++k) qa[k] = *(const GAS bf16x8*)(qp2 + 16 * k); } }
        } else if (wave == 0) {
            attn_block(Ks, Vs, biasM, qa, ATT + (size_t)rowa * RW + heada * 64, 0, 0, lane & 7, (lane >> 3) & 3, sinka, lane);
        }
    }
}
__device__ __forceinline__ void state_copies(Frame& F, const Args& a, int w0, int wstride) {
    unsigned char* ws = a.ws; float* out = a.out;
    const bf16* QKV = (const bf16*)(ws + WS_QKV); const bf16* RWB = (const bf16*)(ws + WS_RWB); const float* cwk = a.in[2]; const float* cwv = a.in[3];
    const size_t gt = (size_t)w0 * 512 + F.tid, GT = (size_t)wstride * 512;
    for (size_t i = gt; i < (size_t)NB * 128 * 32; i += GT) { const int c = (int)(i & 31) * 4, j = (int)((i >> 5) & 127), b = (int)(i >> 12);
        const bf16* src = QKV + (size_t)(b * SEQ + SEQ - 128 + j) * QKVW + 512 + c; const u32x2_t k2 = *(const GAS u32x2_t*)src, v2 = *(const GAS u32x2_t*)(src + 128);
        *(GAS f32x4*)(out + O_PWK + 4 * i) = (f32x4){bflo(k2.x), bfhi(k2.x), bflo(k2.y), bfhi(k2.y)}; *(GAS f32x4*)(out + O_PWV + 4 * i) = (f32x4){bflo(v2.x), bfhi(v2.x), bflo(v2.y), bfhi(v2.y)}; }
    for (size_t i = gt; i < (size_t)DECB * 128 * 32; i += GT) { const int c = (int)(i & 31) * 4, j = (int)((i >> 5) & 127), b = (int)(i >> 12);
        if (j < 128 - DECT) { *(GAS f32x4*)(out + O_SWK + 4 * i) = *(const GAS f32x4*)(cwk + (size_t)(b * 128 + j + DECT) * 128 + c); *(GAS f32x4*)(out + O_SWV + 4 * i) = *(const GAS f32x4*)(cwv + (size_t)(b * 128 + j + DECT) * 128 + c); }
        else { const bf16* src = QKV + (size_t)(MP + b * DECT + j - (128 - DECT)) * QKVW + 512 + c; const u32x2_t k2 = *(const GAS u32x2_t*)src, v2 = *(const GAS u32x2_t*)(src + 128);
            *(GAS f32x4*)(out + O_SWK + 4 * i) = (f32x4){bflo(k2.x), bfhi(k2.x), bflo(k2.y), bfhi(k2.y)}; *(GAS f32x4*)(out + O_SWV + 4 * i) = (f32x4){bflo(v2.x), bfhi(v2.x), bflo(v2.y), bfhi(v2.y)}; } }
    for (size_t i = gt; i < (size_t)NB * (RWS / 4); i += GT) { const int c = (int)(i % (RWS / 4)) * 4, b = (int)(i / (RWS / 4)); const u32x2_t r2 = *(const GAS u32x2_t*)(RWB + (size_t)(b * SEQ + SEQ - 1) * RWS + c);
        *(GAS f32x4*)(out + O_PSH + 4 * i) = (f32x4){bflo(r2.x), bfhi(r2.x), bflo(r2.y), bfhi(r2.y)}; }
    for (size_t i = gt; i < (size_t)DECB * (RWS / 4); i += GT) { const int c = (int)(i % (RWS / 4)) * 4, b = (int)(i / (RWS / 4)); const u32x2_t r2 = *(const GAS u32x2_t*)(RWB + (size_t)(MP + b * DECT + DECT - 1) * RWS + c);
        *(GAS f32x4*)(out + O_SSH + 4 * i) = (f32x4){bflo(r2.x), bfhi(r2.x), bflo(r2.y), bfhi(r2.y)}; }
}

__device__ __forceinline__ void rwkv_scan_sample(Frame& F, const Args& a, int b) {
    unsigned char* ws = a.ws;
    const bf16* RWB = (const bf16*)(ws + WS_RWB); const float* DEC = a.out; const bf16* ASIG = (const bf16*)(ws + WS_ASIG); bf16* GO = (bf16*)(ws + WS_RWO);
    const float* sshift = a.in[4]; const float* swkv = a.in[5]; const float* mu = a.in[11]; const float* k_k = a.in[17]; const float* k_a = a.in[18]; const float* r_k = a.in[19];
    const float* lnx_g = a.in[20]; const float* lnx_b = a.in[21];
    const int h = F.wave, lane = F.lane, cch = h * 64 + lane, row0 = MP + b * DECT;
    LAS float* V6 = (LAS float*)F.lds + h * (DECT * 6 * 64 + 64);
    LAS float* BONw = V6 + DECT * 6 * 64;
#pragma unroll
    for (int t = 0; t < DECT; ++t) { const int row = row0 + t; const bf16* pr = RWB + (size_t)row * RWS;
        const float p_r = bf2f(pr[cch]), p_k = bf2f(pr[RW + cch]), p_v = bf2f(pr[2 * RW + cch]);
        float q_r, q_k, q_v;
        if (t == 0) { const float* sp = sshift + (size_t)b * RWS; q_r = sp[cch]; q_k = sp[RW + cch]; q_v = sp[2 * RW + cch]; }
        else { q_r = bf2f(pr[cch - RWS]); q_k = bf2f(pr[RW + cch - RWS]); q_v = bf2f(pr[2 * RW + cch - RWS]); }
        const float r = p_r + mu[cch] * (q_r - p_r), kx = p_k + mu[RW + cch] * (q_k - p_k), v = p_v + mu[2 * RW + cch] * (q_v - p_v);
        const size_t o = (size_t)row * RW + cch; const float w = __expf(DEC[o]); const float as = bf2f(ASIG[o]);
        const float kkr = kx * k_k[cch]; const float ss = wave_sum(kkr * kkr); const float kk = kkr * __builtin_amdgcn_rsqf(fmaxf(ss, 1e-24f));
        const float kp = kx * (1.0f + (as - 1.0f) * k_a[cch]); const float bon = wave_sum(r * kp * r_k[cch]);
        LAS float* vt = V6 + t * 384; vt[lane] = r; vt[64 + lane] = w; vt[128 + lane] = kp; vt[192 + lane] = -kk; vt[256 + lane] = kk * as; vt[320 + lane] = v;
        if (lane == 0) BONw[t] = bon; }
    float S[64];
    { const GAS f32x4* sp = (const GAS f32x4*)(swkv + ((size_t)(b * 8 + h) * 64 + lane) * 64);
#pragma unroll
      for (int q = 0; q < 16; ++q) { const f32x4 x = sp[q]; S[4 * q] = x[0]; S[4 * q + 1] = x[1]; S[4 * q + 2] = x[2]; S[4 * q + 3] = x[3]; } }
    asm volatile("s_waitcnt lgkmcnt(0)" ::: "memory");
#pragma unroll 1
    for (int t = 0; t < DECT; ++t) { const LAS float* vt = V6 + t * 384; const float vi = vt[320 + lane];
        float sa = 0.f;
#pragma unroll
        for (int q = 0; q < 16; ++q) { const f32x4 a4 = *(const LAS f32x4*)(vt + 192 + 4 * q); sa += S[4 * q] * a4[0] + S[4 * q + 1] * a4[1] + S[4 * q + 2] * a4[2] + S[4 * q + 3] * a4[3]; }
        float y = 0.f;
#pragma unroll
        for (int q = 0; q < 16; ++q) { const f32x4 w4 = *(const LAS f32x4*)(vt + 64 + 4 * q), b4 = *(const LAS f32x4*)(vt + 256 + 4 * q), k4 = *(const LAS f32x4*)(vt + 128 + 4 * q), r4 = *(const LAS f32x4*)(vt + 4 * q);
#pragma unroll
            for (int e = 0; e < 4; ++e) { const float sn = S[4 * q + e] * w4[e] + sa * b4[e] + vi * k4[e]; S[4 * q + e] = sn; y += sn * r4[e]; } }
        const float mean = wave_sum(y) * (1.0f / 64.0f); const float d = y - mean; const float var = wave_sum(d * d) * (1.0f / 64.0f);
        float yn = d * __builtin_amdgcn_rsqf(var + 64e-5f); yn = yn * lnx_g[cch] + lnx_b[cch] + BONw[t] * vi;
        const size_t o = (size_t)(row0 + t) * RW + cch; GO[o] = (bf16)f2bf(yn * bf2f(GO[o])); }
    { GAS f32x4* so = (GAS f32x4*)(a.out + O_SWKV + ((size_t)(b * 8 + h) * 64 + lane) * 64);
#pragma unroll
      for (int q = 0; q < 16; ++q) so[q] = (f32x4){S[4 * q], S[4 * q + 1], S[4 * q + 2], S[4 * q + 3]}; }
}

constexpr int KP = 72;
constexpr int L_AT = 0, L_RT = 9216, L_BT = 18432, L_KT = 27648, L_AAK = 36864, L_ARB = 46080, L_ARK = 55296, L_AAB = 64512, L_TM = 73728, L_S0B = 82944  ,
              L_BH = 101376, L_KH = 109568, L_VN = 117760, L_CL = 125952, L_LC = 143360, L_BON = 143616, L_SEG = 143872, L_ST = 145920, L_GB = 146944, L_RW_END = 156160;
constexpr int L_CT = 156160;
constexpr int CLP = 68;
constexpr int L_TL = L_AAK, L_LA = L_ARB, L_SG0 = L_ARK, L_SG1 = L_AAB, L_ASG = L_BT;
constexpr int L_XG = 146944  , L_SA = L_KT;
__device__ __forceinline__ void unpack8(const v4u w, float (&o)[8]) { o[0] = bflo(w.x); o[1] = bfhi(w.x); o[2] = bflo(w.y); o[3] = bfhi(w.y); o[4] = bflo(w.z); o[5] = bfhi(w.z); o[6] = bflo(w.w); o[7] = bfhi(w.w); }
__device__ __forceinline__ v4u packf8(const float (&v)[8]) { v4u w; w.x = cvtpk(v[0], v[1]); w.y = cvtpk(v[2], v[3]); w.z = cvtpk(v[4], v[5]); w.w = cvtpk(v[6], v[7]); return w; }
__device__ __forceinline__ bf16x8 trfrag(const LAS bf16* p, int second_off) {
    const v4i16_t lo = lds_tr16(p), hi = lds_tr16(p + second_off); return (bf16x8){lo[0], lo[1], lo[2], lo[3], hi[0], hi[1], hi[2], hi[3]}; }
__device__ __forceinline__ bf16x8 acc8_to_bf(const f32x16& x, int s) {
    v4u w; w.x = cvtpk(x[8 * s + 0], x[8 * s + 1]); w.y = cvtpk(x[8 * s + 2], x[8 * s + 3]); w.z = cvtpk(x[8 * s + 4], x[8 * s + 5]); w.w = cvtpk(x[8 * s + 6], x[8 * s + 7]);
    return __builtin_bit_cast(bf16x8, w); }
__device__ __forceinline__ f32x16 zero16() { f32x16 z;
#pragma unroll
    for (int r = 0; r < 16; ++r) z[r] = 0.f;
    return z; }
#define MFMA32(A, B, C) __builtin_amdgcn_mfma_f32_32x32x16_bf16((A), (B), (C), 0, 0, 0)
__device__ __forceinline__ void store_tile_nm(LAS bf16* dst, const f32x16& acc, int nrow, int m0, int hh) {
#pragma unroll
    for (int rq = 0; rq < 4; ++rq) { u32x2_t w; w.x = cvtpk(acc[4 * rq + 0], acc[4 * rq + 1]); w.y = cvtpk(acc[4 * rq + 2], acc[4 * rq + 3]);
        *(LAS u32x2_t*)(dst + nrow * KP + m0 + 8 * rq + 4 * hh) = w; }
}
__device__ __forceinline__ void rwkv_prep_mfma(Frame& F, const Args& a, int ustart, int ustride, int uend) {
    unsigned char* ws = a.ws;
    const bf16* RWB = (const bf16*)(ws + WS_RWB); float* DEC = a.out; bf16* ASIG = (bf16*)(ws + WS_ASIG); bf16* GO = (bf16*)(ws + WS_RWO);
    const bf16* W2T = (const bf16*)(ws + WS_W2T); const bf16* A2T = (const bf16*)(ws + WS_A2T); const bf16* G2T = (const bf16*)(ws + WS_G2T);
    const float* sshift = a.in[4]; const float* mu = a.in[11]; const float* w0 = a.in[12]; const float* a0 = a.in[14];
    LAS bf16* TL = (LAS bf16*)F.lds; LAS bf16* LA = TL + 32 * KP; LAS bf16* SG0 = LA + 32 * KP; LAS bf16* SG1 = SG0 + 32 * KP;
    const int tid = F.tid, lane = F.lane, wave = F.wave, r32 = lane & 31, hh = lane >> 5;
    const int tok = tid >> 4, part = tid & 15, c0 = 3 * RW + 16 * part;
    const float kx = (part < 4) ? -2.0f * LOG2E : -LOG2E, sA = (part < 4) ? 2.0f : (part < 8) ? 0.0f : 1.0f, sB = (part >= 4 && part < 8) ? 1.0f : 0.0f, sC = (part < 4) ? -1.0f : 0.0f;
    LAS bf16* dstb = (part < 4) ? TL : (part < 8) ? LA : (part < 12) ? SG0 : SG1; const int dcol = 16 * (part & 3);
#define PREP_ROWS(u_, cur0, cur1, prv0, prv1) do { const int row_ = (u_) * 32 + tok; const bf16* pr_ = RWB + (size_t)row_ * RWS + c0; cur0 = *(const GAS v4u*)pr_; cur1 = *(const GAS v4u*)(pr_ + 8); \
        const bool hp_ = (row_ < MP) ? ((row_ & (SEQ - 1)) != 0) : (((row_ - MP) & (DECT - 1)) != 0); const bf16* pq_ = hp_ ? pr_ - RWS : pr_; prv0 = *(const GAS v4u*)pq_; prv1 = *(const GAS v4u*)(pq_ + 8); } while (0)
    const int h = wave;
    v4u nc0, nc1, np0, np1;
    if (ustart < uend) PREP_ROWS(ustart, nc0, nc1, np0, np1);
    float mu16[16];
#pragma unroll
    for (int e = 0; e < 16; ++e) mu16[e] = mu[c0 + e];
    for (int u = ustart; u < uend; u += ustride) {
        __syncthreads();
        bf16x8 bwn[8];
#pragma unroll
        for (int ks = 0; ks < 8; ++ks) bwn[ks] = *(const GAS bf16x8*)(W2T + (size_t)(h * 64 + r32) * 64 + 16 * (ks & 3) + 8 * hh);
        { const int row = u * 32 + tok; const v4u cv[2] = {nc0, nc1}; const v4u pv[2] = {np0, np1};
          const bool hp = (row < MP) ? ((row & (SEQ - 1)) != 0) : (((row - MP) & (DECT - 1)) != 0);
#pragma unroll
          for (int q = 0; q < 2; ++q) { float pc[8], pp[8], o8[8]; unpack8(cv[q], pc); unpack8(pv[q], pp);
              if (!hp) {
                  if (row < MP) {
#pragma unroll
                      for (int e = 0; e < 8; ++e) pp[e] = 0.f;
                  } else {
#pragma unroll
                      for (int e = 0; e < 8; ++e) pp[e] = sshift[(size_t)((row - MP) >> 3) * RWS + c0 + 8 * q + e]; } }
#pragma unroll
              for (int e = 0; e < 8; ++e) { const float xs = pc[e] + mu16[8 * q + e] * (pp[e] - pc[e]); o8[e] = sA * __builtin_amdgcn_rcpf(1.0f + __builtin_amdgcn_exp2f(kx * xs)) + (sB * xs + sC); }
              *(LAS v4u*)(dstb + tok * KP + dcol + 8 * q) = packf8(o8); } }
        if (u + ustride < uend) PREP_ROWS(u + ustride, nc0, nc1, np0, np1);
        __syncthreads();
#pragma unroll 1
        for (int step = 0; step < 6; ++step) { const int prod = step >> 1, jt = step & 1, ch = h * 64 + 32 * jt + r32;
            bf16x8 bw[8];
#pragma unroll
            for (int ks = 0; ks < 8; ++ks) bw[ks] = bwn[ks];
            if (step < 5) { const int pn_ = (step + 1) >> 1, jn_ = (step + 1) & 1, chn = h * 64 + 32 * jn_ + r32;
                const bf16* WT = (pn_ == 0) ? W2T : (pn_ == 1) ? A2T : G2T; const int ldw = (pn_ == 2) ? 128 : 64, kmask = (pn_ == 2) ? 7 : 3;
#pragma unroll
                for (int ks = 0; ks < 8; ++ks) bwn[ks] = *(const GAS bf16x8*)(WT + (size_t)chn * ldw + 16 * (ks & kmask) + 8 * hh); }
            const float bias = (prod == 0) ? w0[ch] : (prod == 1) ? a0[ch] : 0.f;
            f32x16 acc = zero16();
            const LAS bf16* As0 = (prod == 0) ? TL : (prod == 1) ? LA : SG0;
#pragma unroll
            for (int ks = 0; ks < 4; ++ks) acc = MFMA32(*(const LAS bf16x8*)(As0 + r32 * KP + 16 * ks + 8 * hh), bw[ks], acc);
            if (prod == 2) {
#pragma unroll
                for (int ks = 0; ks < 4; ++ks) acc = MFMA32(*(const LAS bf16x8*)(SG1 + r32 * KP + 16 * ks + 8 * hh), bw[4 + ks], acc); }
            LAS float* scf = (LAS float*)(F.lds + 4 * 32 * KP * 2 + wave * 4096); LAS bf16* sch = (LAS bf16*)scf;
            const size_t ob = (size_t)(u * 32) * RW + h * 64 + 32 * jt;
            if (prod == 0) {
#pragma unroll
                for (int r = 0; r < 16; ++r) { const float sg = __builtin_amdgcn_rcpf(1.0f + __builtin_amdgcn_exp2f(-LOG2E * (acc[r] + bias))); scf[((r & 3) + 8 * (r >> 2) + 4 * hh) * 32 + r32] = -0.6065306597126334f * sg; }
#pragma unroll
                for (int q = 0; q < 4; ++q) { const int idx = q * 64 + lane, rw_ = idx >> 3, c4 = idx & 7; *(GAS f32x4*)(DEC + ob + (size_t)rw_ * RW + 4 * c4) = *(const LAS f32x4*)(scf + rw_ * 32 + 4 * c4); }
            } else {
#pragma unroll
                for (int r = 0; r < 16; ++r) { const float x = acc[r] + bias; const float y = (prod == 1) ? __builtin_amdgcn_rcpf(1.0f + __builtin_amdgcn_exp2f(-LOG2E * x)) : x; sch[((r & 3) + 8 * (r >> 2) + 4 * hh) * 32 + r32] = (bf16)f2bf(y); }
                bf16* dst = (prod == 1) ? ASIG : GO;
#pragma unroll
                for (int q = 0; q < 2; ++q) { const int idx = q * 64 + lane, rw_ = idx >> 2, c8 = idx & 3; *(GAS v4u*)(dst + ob + (size_t)rw_ * RW + 8 * c8) = *(const LAS v4u*)(sch + rw_ * 32 + 8 * c8); } }
            asm volatile("s_waitcnt lgkmcnt(0)" ::: "memory"); }
    }
#undef PREP_ROWS
}

__device__ __forceinline__ void mtile(const LAS bf16* Asrc, const LAS bf16* Bsrc, int sm, int tn, LAS bf16* dst, int lim, LAS float* diag, int r32, int hh) {
    f32x16 acc = zero16();
#pragma unroll
    for (int ks = 0; ks < 4; ++ks) acc = MFMA32(*(const LAS bf16x8*)(Asrc + (32 * sm + r32) * KP + 16 * ks + 8 * hh), *(const LAS bf16x8*)(Bsrc + (32 * tn + r32) * KP + 16 * ks + 8 * hh), acc);
    const int t = 32 * tn + r32;
#pragma unroll
    for (int rq = 0; rq < 4; ++rq) { const int s0 = 32 * sm + 8 * rq + 4 * hh; float v4[4];
#pragma unroll
        for (int e = 0; e < 4; ++e) v4[e] = (s0 + e < t + lim) ? acc[4 * rq + e] : 0.f;
        u32x2_t w; w.x = cvtpk(v4[0], v4[1]); w.y = cvtpk(v4[2], v4[3]); *(LAS u32x2_t*)(dst + t * KP + s0) = w;
        if (diag != nullptr && tn == sm) *(LAS f32x4*)(diag + t * 36 + 8 * rq + 4 * hh) = (f32x4){v4[0], v4[1], v4[2], v4[3]}; }
}
template <bool DRY, int SKIP = 0> __device__ __forceinline__ void rwkv_chunked(Frame& F, const Args& a, int b, int h) {
    unsigned char* ws = a.ws;
    const bf16* RWB = (const bf16*)(ws + WS_RWB); bf16* GO = (bf16*)(ws + WS_RWO); const float* DEC = a.out; const bf16* ASIG = (const bf16*)(ws + WS_ASIG);
    const float* w0p = a.in[12]; const float* a0p = a.in[14];
    const float* mu = a.in[11]; const float* k_k = a.in[17]; const float* k_a = a.in[18]; const float* r_k = a.in[19]; const float* lnx_g = a.in[20]; const float* lnx_b = a.in[21];
    LAS unsigned char* L = F.lds;
    LAS bf16* At = (LAS bf16*)(L + L_AT); LAS bf16* Rt = (LAS bf16*)(L + L_RT); LAS bf16* Bt = (LAS bf16*)(L + L_BT); LAS bf16* Kt = (LAS bf16*)(L + L_KT);
    LAS bf16* Aak = (LAS bf16*)(L + L_AAK); LAS bf16* Arb = (LAS bf16*)(L + L_ARB); LAS bf16* Ark = (LAS bf16*)(L + L_ARK); LAS bf16* Aab = (LAS bf16*)(L + L_AAB);
    LAS bf16* Tm = (LAS bf16*)(L + L_TM); LAS bf16* XGt = (LAS bf16*)(L + L_XG); LAS bf16* SAt = (LAS bf16*)(L + L_SA);
    LAS bf16* Bh = (LAS bf16*)(L + L_BH); LAS bf16* Kh = (LAS bf16*)(L + L_KH); LAS bf16* Vn = (LAS bf16*)(L + L_VN);
    LAS bf16* TL = (LAS bf16*)(L + L_TL); LAS bf16* LA = (LAS bf16*)(L + L_LA); LAS bf16* SG0 = (LAS bf16*)(L + L_SG0); LAS bf16* SG1 = (LAS bf16*)(L + L_SG1); LAS bf16* ASg = (LAS bf16*)(L + L_ASG); LAS bf16* Gb = (LAS bf16*)(L + L_GB);
    LAS float* CL = (LAS float*)(L + L_CL); LAS float* Lc = (LAS float*)(L + L_LC); LAS float* BON = (LAS float*)(L + L_BON); LAS float* SEG = (LAS float*)(L + L_SEG); LAS float* ST = (LAS float*)(L + L_ST);
    const int tid0 = F.tid, wave = F.wave;
    __syncthreads();
    for (int i = tid0; i < (9216 * 3) / 16; i += 512) ((LAS v4u*)(L + L_TM))[i] = (v4u){0u, 0u, 0u, 0u};
    LAS float* CT = (LAS float*)(L + L_CT);
    for (int i = tid0; i < 896; i += 512) { float v; const int hc = h * 64;
        if (i < 64) v = mu[hc + i]; else if (i < 128) v = mu[RW + hc + i - 64]; else if (i < 192) v = mu[2 * RW + hc + i - 128]; else if (i < 256) v = k_k[hc + i - 192]; else if (i < 320) v = k_a[hc + i - 256];
        else if (i < 384) v = r_k[hc + i - 320]; else if (i < 640) v = mu[3 * RW + i - 384]; else if (i < 704) v = w0p[hc + i - 640]; else if (i < 768) v = a0p[hc + i - 704]; else if (i < 832) v = lnx_g[hc + i - 768]; else v = lnx_b[hc + i - 832];
        CT[i] = v; }
    f32x16 sacc = zero16();
    const int row0 = b * SEQ;
    v4u pf[6], pd[3];
    { const int tk = tid0 >> 3, jq0 = tid0 & 7; const bf16* pr = RWB + (size_t)(row0 + tk) * RWS + h * 64 + 8 * jq0; const bf16* pq = (tk != 0) ? pr - RWS : pr;
      pf[0] = *(const GAS v4u*)pr; pf[1] = *(const GAS v4u*)(pr + RW); pf[2] = *(const GAS v4u*)(pr + 2 * RW); pf[3] = *(const GAS v4u*)pq; pf[4] = *(const GAS v4u*)(pq + RW); pf[5] = *(const GAS v4u*)(pq + 2 * RW);
      const size_t o = (size_t)(row0 + tk) * RW + h * 64 + 8 * jq0; pd[0] = *(const GAS v4u*)(DEC + o); pd[1] = *(const GAS v4u*)(DEC + o + 4); pd[2] = *(const GAS v4u*)(ASIG + o); }
#define BARL() do { asm volatile("s_waitcnt lgkmcnt(0)" ::: "memory"); __builtin_amdgcn_s_barrier(); asm volatile("" ::: "memory"); } while (0)
    __syncthreads();
#pragma unroll 1
    for (int c = 0; c < SEQ / 64; ++c) {
        int tid = tid0; asm volatile("" : "+v"(tid));
        const int lane = tid & 63, r32 = lane & 31, hh = lane >> 5, q4 = (lane & 15) >> 2, p4 = lane & 3, dblk = (lane >> 4) & 1;
        const int troff = (8 * hh + q4) * 32 + 16 * dblk + 4 * p4;
        const int tok = tid >> 3, jq = tid & 7, cj = h * 64 + 8 * jq;
        const int cur = c & 1;
        LAS bf16* S0cur = (LAS bf16*)(L + L_S0B + cur * 9216); LAS bf16* S0nxt = (LAS bf16*)(L + L_S0B + (cur ^ 1) * 9216);
        BARL();
        const int rowt = row0 + c * 64 + tok; const bool has_prev = (rowt & (SEQ - 1)) != 0;
        const v4u ld_r = pf[0], ld_k = pf[1], ld_v = pf[2], ld_qr = pf[3], ld_qk = pf[4], ld_qv = pf[5];
        const v4u ld_d0 = pd[0], ld_d1 = pd[1], ld_as = pd[2];
        float rr[8], kq[8], vv[8], aa[8], bb[8], lwv[8];
        { float p_r[8], p_k[8], p_v[8], q_r[8], q_k[8], q_v[8];
          unpack8(ld_r, p_r); unpack8(ld_k, p_k); unpack8(ld_v, p_v); unpack8(ld_qr, q_r); unpack8(ld_qk, q_k); unpack8(ld_qv, q_v);
          if (!has_prev) {
#pragma unroll
              for (int e = 0; e < 8; ++e) { q_r[e] = 0.f; q_k[e] = 0.f; q_v[e] = 0.f; } }
          float asg[8]; unpack8(ld_as, asg);
          { const f32x4 d0 = __builtin_bit_cast(f32x4, ld_d0), d1 = __builtin_bit_cast(f32x4, ld_d1);
#pragma unroll
            for (int e = 0; e < 4; ++e) { lwv[e] = d0[e]; lwv[4 + e] = d1[e]; }
            *(LAS f32x4*)(CL + tok * CLP + 8 * jq) = d0; *(LAS f32x4*)(CL + tok * CLP + 8 * jq + 4) = d1; }
          float ss = 0.f, bon = 0.f; float kkr[8];
#pragma unroll
          for (int e = 0; e < 8; ++e) { const float mr = CT[8 * jq + e], mk = CT[64 + 8 * jq + e], mv = CT[128 + 8 * jq + e];
              rr[e] = p_r[e] + mr * (q_r[e] - p_r[e]); const float kx = p_k[e] + mk * (q_k[e] - p_k[e]); vv[e] = p_v[e] + mv * (q_v[e] - p_v[e]);
              kkr[e] = kx * CT[192 + 8 * jq + e]; ss += kkr[e] * kkr[e]; kq[e] = kx * (1.0f + (asg[e] - 1.0f) * CT[256 + 8 * jq + e]); bon += rr[e] * kq[e] * CT[320 + 8 * jq + e]; }
          ss += pg8::dpp_z<0xB1>(ss); ss += pg8::dpp_z<0x4E>(ss); ss += pg8::dpp_z<0x141>(ss);
          bon += pg8::dpp_z<0xB1>(bon); bon += pg8::dpp_z<0x4E>(bon); bon += pg8::dpp_z<0x141>(bon);
          const float rn = __builtin_amdgcn_rsqf(fmaxf(ss, 1e-24f));
#pragma unroll
          for (int e = 0; e < 8; ++e) { const float kk = kkr[e] * rn; aa[e] = -kk; bb[e] = kk * asg[e]; }
          if (jq == 0) BON[tok] = bon; }
        { const int cn = (c + 1 < SEQ / 64) ? c + 1 : c; const bf16* pr = RWB + (size_t)(row0 + cn * 64 + tok) * RWS + cj; const bf16* pq = pr - RWS;
          pf[0] = *(const GAS v4u*)pr; pf[1] = *(const GAS v4u*)(pr + RW); pf[2] = *(const GAS v4u*)(pr + 2 * RW); pf[3] = *(const GAS v4u*)pq; pf[4] = *(const GAS v4u*)(pq + RW); pf[5] = *(const GAS v4u*)(pq + 2 * RW);
          const size_t o = (size_t)(row0 + cn * 64 + tok) * RW + cj; pd[0] = *(const GAS v4u*)(DEC + o); pd[1] = *(const GAS v4u*)(DEC + o + 4); pd[2] = *(const GAS v4u*)(ASIG + o); }
        BARL();
        { const int j = tid & 63, seg = tid >> 6; float c8[8]; float run = 0.f;
#pragma unroll
          for (int e = 0; e < 8; ++e) { run += CL[(8 * seg + e) * CLP + j]; c8[e] = run; }
          SEG[seg * 64 + j] = run;
          BARL();
          float pre = 0.f, tot = 0.f;
#pragma unroll
          for (int s2 = 0; s2 < 8; ++s2) { const float x = SEG[s2 * 64 + j]; tot += x; pre += (s2 < seg) ? x : 0.f; }
#pragma unroll
          for (int e = 0; e < 8; ++e) CL[(8 * seg + e) * CLP + j] = c8[e] + pre;
          if (seg == 0) Lc[j] = __builtin_amdgcn_exp2f(tot * LOG2E); }
        BARL();
        if (!(SKIP & 8)) {
          const f32x4 c0 = *(const LAS f32x4*)(CL + tok * CLP + 8 * jq), c1 = *(const LAS f32x4*)(CL + tok * CLP + 8 * jq + 4);
          const f32x4 t0 = *(const LAS f32x4*)(Lc + 8 * jq), t1 = *(const LAS f32x4*)(Lc + 8 * jq + 4);
          float oat[8], ort[8], obt[8], okt[8], obh[8], okh[8];
#pragma unroll
          for (int e = 0; e < 8; ++e) { const float cl = (e < 4 ? c0[e] : c1[e - 4]), et = (e < 4 ? t0[e] : t1[e - 4]);
              const float e1 = __builtin_amdgcn_exp2f(cl * LOG2E), e2 = __builtin_amdgcn_rcpf(e1), e4 = __builtin_amdgcn_exp2f((cl - lwv[e]) * LOG2E);
              oat[e] = aa[e] * e4; ort[e] = rr[e] * e1; obt[e] = bb[e] * e2; okt[e] = kq[e] * e2; obh[e] = obt[e] * et; okh[e] = okt[e] * et; }
          const int kc = tok * KP + 8 * jq, km = (jq >> 2) * 2048 + tok * 32 + 8 * (jq & 3);
          *(LAS v4u*)(At + kc) = packf8(oat); *(LAS v4u*)(Rt + kc) = packf8(ort); *(LAS v4u*)(Bt + kc) = packf8(obt); *(LAS v4u*)(Kt + kc) = packf8(okt);
          *(LAS v4u*)(Bh + km) = packf8(obh); *(LAS v4u*)(Kh + km) = packf8(okh); *(LAS v4u*)(Vn + km) = packf8(vv); }
        BARL();
        { const int sm = (wave >> 1) & 1, tn = wave & 1; if (wave < 4) mtile(Bt, At, sm, tn, Aab, 0, CL, r32, hh); else mtile(Kt, At, sm, tn, Aak, 0, nullptr, r32, hh); }
        BARL();
        f32x16 xg = zero16();
        if (wave == 0 && !(SKIP & 1)) {
            { const int kb = lane >> 4, cc = lane & 15; float Tr[16]; const LAS float* Ab = CL + (16 * kb) * 36 + 16 * (kb & 1);
              Tr[0] = (cc == 0) ? 1.f : 0.f;
              f32x4 R[16][4];
#pragma unroll
              for (int t = 1; t <= 6; ++t)
#pragma unroll
                  for (int q = 0; q < (t + 3) / 4; ++q) R[t][q] = *(const LAS f32x4*)(Ab + t * 36 + 4 * q);
#pragma unroll
              for (int t = 1; t < 16; ++t) {
                  if (t + 6 < 16) {
#pragma unroll
                      for (int q = 0; q < (t + 6 + 3) / 4; ++q) R[t + 6][q] = *(const LAS f32x4*)(Ab + (t + 6) * 36 + 4 * q); }
                  __builtin_amdgcn_sched_barrier(0);
                  float acc = (t == cc) ? 1.f : 0.f;
#pragma unroll
                  for (int s = 0; s < t; ++s) acc += R[t][s >> 2][s & 3] * Tr[s];
                  Tr[t] = acc; }
#pragma unroll
              for (int t = 0; t < 16; ++t) Tm[(16 * kb + t) * KP + 16 * kb + cc] = (bf16)f2bf(Tr[t]); }
            asm volatile("s_waitcnt lgkmcnt(0)" ::: "memory");
            {
              const int arow = (r32 < 16) ? 16 + r32 : 32 + r32, acol = ((r32 < 16) ? 0 : 32) + 8 * hh;
              const bf16x8 af = *(const LAS bf16x8*)(Aab + arow * KP + acol);
              const int rb = 32 * dblk; const LAS bf16* tp = Tm + (rb + 8 * hh + q4) * KP + rb + 4 * p4;
              const f32x16 W1 = MFMA32(af, trfrag(tp, 4 * KP), zero16());
              f32x16 E = zero16();
#pragma unroll
              for (int s = 0; s < 2; ++s) { const bool on = (s == 0) ? (r32 < 16) : (r32 >= 16); const int base = (s == 0) ? (16 + r32) * KP + 16 + 4 * hh : (32 + r32) * KP + 48 + 4 * hh;
                  u32x2_t lo = *(const LAS u32x2_t*)(Tm + base), hi = *(const LAS u32x2_t*)(Tm + base + 8);
                  if (!on) { lo = (u32x2_t){0u, 0u}; hi = lo; }
                  const v4u aw = (v4u){lo.x, lo.y, hi.x, hi.y};
                  E = MFMA32(__builtin_bit_cast(bf16x8, aw), acc8_to_bf(W1, s), E); }
#pragma unroll
              for (int reg = 0; reg < 16; ++reg) { const int rw = (reg & 3) + 8 * (reg >> 2) + 4 * hh;
                  if (r32 < 16 && reg < 8) Tm[(16 + rw) * KP + r32] = (bf16)f2bf(E[reg]);
                  if (r32 >= 16 && reg >= 8) Tm[(32 + rw) * KP + 16 + r32] = (bf16)f2bf(E[reg]); } }
            asm volatile("s_waitcnt lgkmcnt(0)" ::: "memory");
            {
              f32x16 W2 = zero16();
#pragma unroll
              for (int ks = 0; ks < 2; ++ks) { const bf16x8 af = *(const LAS bf16x8*)(Aab + (32 + r32) * KP + 16 * ks + 8 * hh);
                  const LAS bf16* tp = Tm + (16 * ks + 8 * hh + q4) * KP + 16 * dblk + 4 * p4; W2 = MFMA32(af, trfrag(tp, 4 * KP), W2); }
              f32x16 Fm = zero16();
#pragma unroll
              for (int s = 0; s < 2; ++s) { const int base = (32 + r32) * KP + 32 + 16 * s + 4 * hh; const u32x2_t lo = *(const LAS u32x2_t*)(Tm + base), hi = *(const LAS u32x2_t*)(Tm + base + 8);
                  const v4u aw = (v4u){lo.x, lo.y, hi.x, hi.y}; Fm = MFMA32(__builtin_bit_cast(bf16x8, aw), acc8_to_bf(W2, s), Fm); }
#pragma unroll
              for (int reg = 0; reg < 16; ++reg) { const int rw = (reg & 3) + 8 * (reg >> 2) + 4 * hh; Tm[(32 + rw) * KP + r32] = (bf16)f2bf(Fm[reg]); } }
        } else if (wave < 4) {
#pragma unroll 1
            for (int idx = 3 * (wave - 1); idx < 3 * wave && idx < 8; ++idx) mtile((idx < 4) ? Bt : Kt, Rt, (idx >> 1) & 1, idx & 1, (idx < 4) ? Arb : Ark, 1, nullptr, r32, hh);
        } else {
            const int tm = (wave >> 1) & 1, inn = wave & 1;
#pragma unroll
            for (int ks = 0; ks < 4; ++ks) { const bf16x8 af = *(const LAS bf16x8*)(Aak + (32 * tm + r32) * KP + 16 * ks + 8 * hh); xg = MFMA32(af, trfrag(Vn + inn * 2048 + 16 * ks * 32 + troff, 128), xg); }
#pragma unroll
            for (int ks = 0; ks < 4; ++ks) { const bf16x8 af = *(const LAS bf16x8*)(At + (32 * tm + r32) * KP + 16 * ks + 8 * hh); const bf16x8 bf = *(const LAS bf16x8*)(S0cur + (32 * inn + r32) * KP + 16 * ks + 8 * hh); xg = MFMA32(af, bf, xg); }
            store_tile_nm(XGt, xg, 32 * inn + r32, 32 * tm, hh);
        }
        BARL();
        f32x16 yv = zero16(); float mean = 0.f, rstd = 0.f; u32x2_t gq[4] = {};
        if (wave < 4) { const int tm = (wave >> 1) & 1, inn = wave & 1; f32x16 sa = zero16();
#pragma unroll
            for (int ks = 0; ks < 4; ++ks) { const bf16x8 af = *(const LAS bf16x8*)(Tm + (32 * tm + r32) * KP + 16 * ks + 8 * hh); const bf16x8 bf = *(const LAS bf16x8*)(XGt + (32 * inn + r32) * KP + 16 * ks + 8 * hh); sa = MFMA32(af, bf, sa); }
            store_tile_nm(SAt, sa, 32 * inn + r32, 32 * tm, hh);
        } else if (!(SKIP & 16)) { const int im = (wave >> 1) & 1, tn = wave & 1;
            { const size_t rowo = (size_t)(row0 + c * 64 + 32 * tn + r32) * RW + h * 64 + 32 * im + 4 * hh;
#pragma unroll
              for (int rq = 0; rq < 4; ++rq) gq[rq] = *(const GAS u32x2_t*)(GO + rowo + 8 * rq); }
#pragma unroll
            for (int ks = 0; ks < 4; ++ks) yv = MFMA32(*(const LAS bf16x8*)(S0cur + (32 * im + r32) * KP + 16 * ks + 8 * hh), *(const LAS bf16x8*)(Rt + (32 * tn + r32) * KP + 16 * ks + 8 * hh), yv);
#pragma unroll
            for (int ks = 0; ks < 4; ++ks) yv = MFMA32(trfrag(Vn + im * 2048 + 16 * ks * 32 + troff, 128), *(const LAS bf16x8*)(Ark + (32 * tn + r32) * KP + 16 * ks + 8 * hh), yv); }
        BARL();
        if (SKIP & 16) {} else if (wave < 4) { const int jm = (wave >> 1) & 1, inn = wave & 1;
#pragma unroll
            for (int rq = 0; rq < 4; ++rq) { const f32x4 l4 = *(const LAS f32x4*)(Lc + 32 * jm + 8 * rq + 4 * hh);
#pragma unroll
                for (int e = 0; e < 4; ++e) sacc[4 * rq + e] *= l4[e]; }
#pragma unroll
            for (int ks = 0; ks < 4; ++ks) { const bf16x8 bf = *(const LAS bf16x8*)(SAt + (32 * inn + r32) * KP + 16 * ks + 8 * hh); sacc = MFMA32(trfrag(Bh + jm * 2048 + 16 * ks * 32 + troff, 128), bf, sacc); }
#pragma unroll
            for (int ks = 0; ks < 4; ++ks) sacc = MFMA32(trfrag(Kh + jm * 2048 + 16 * ks * 32 + troff, 128), trfrag(Vn + inn * 2048 + 16 * ks * 32 + troff, 128), sacc);
            store_tile_nm(S0nxt, sacc, 32 * inn + r32, 32 * jm, hh);
        } else { const int im = (wave >> 1) & 1, tn = wave & 1;
#pragma unroll
            for (int ks = 0; ks < 4; ++ks) yv = MFMA32(*(const LAS bf16x8*)(SAt + (32 * im + r32) * KP + 16 * ks + 8 * hh), *(const LAS bf16x8*)(Arb + (32 * tn + r32) * KP + 16 * ks + 8 * hh), yv);
            float s1 = 0.f, s2 = 0.f;
#pragma unroll
            for (int r = 0; r < 16; ++r) { s1 += yv[r]; s2 += yv[r] * yv[r]; }
            s1 += __shfl_xor(s1, 32); s2 += __shfl_xor(s2, 32);
            if (hh == 0) { ST[((im * 2 + tn) * 32 + r32) * 2] = s1; ST[((im * 2 + tn) * 32 + r32) * 2 + 1] = s2; }
            mean = s1; rstd = s2; }
        BARL();
        if (wave >= 4) { const int im = (wave >> 1) & 1, tn = wave & 1;
            const float o1 = ST[(((im ^ 1) * 2 + tn) * 32 + r32) * 2], o2 = ST[(((im ^ 1) * 2 + tn) * 32 + r32) * 2 + 1];
            const float mu_ = (mean + o1) * (1.0f / 64.0f); const float var = (rstd + o2) * (1.0f / 64.0f) - mu_ * mu_; const float rs_ = __builtin_amdgcn_rsqf(fmaxf(var, 0.f) + 64e-5f);
            const int t = 32 * tn + r32; const float bon = BON[t]; const size_t rowo = (size_t)(row0 + c * 64 + t) * RW;
#pragma unroll
            for (int rq = 0; rq < 4; ++rq) { const int i0 = 32 * im + 8 * rq + 4 * hh, cch = h * 64 + i0;
                const f32x4 g4 = *(const LAS f32x4*)(CT + 768 + i0), b4 = *(const LAS f32x4*)(CT + 832 + i0);
                const u32x2_t vw = *(const LAS u32x2_t*)(Vn + (i0 >> 5) * 2048 + t * 32 + (i0 & 31)); const u32x2_t gw = gq[rq];
                const float v0 = bflo(vw.x), v1 = bfhi(vw.x), v2 = bflo(vw.y), v3 = bfhi(vw.y);
                const float y0 = ((yv[4 * rq + 0] - mu_) * rs_ * g4[0] + b4[0] + bon * v0) * bflo(gw.x), y1 = ((yv[4 * rq + 1] - mu_) * rs_ * g4[1] + b4[1] + bon * v1) * bfhi(gw.x);
                const float y2 = ((yv[4 * rq + 2] - mu_) * rs_ * g4[2] + b4[2] + bon * v2) * bflo(gw.y), y3 = ((yv[4 * rq + 3] - mu_) * rs_ * g4[3] + b4[3] + bon * v3) * bfhi(gw.y);
                u32x2_t w; w.x = cvtpk(y0, y1); w.y = cvtpk(y2, y3); if (DRY) asm volatile("" :: "v"(w.x), "v"(w.y)); else *(GAS u32x2_t*)(GO + rowo + cch) = w; } }
    }
    const int lane = tid0 & 63, r32 = lane & 31, hh = lane >> 5;
    if (wave < 4) { const int jm = (wave >> 1) & 1, inn = wave & 1; float* so = a.out + O_PWKV + ((size_t)(b * 8 + h) * 64 + 32 * inn + r32) * 64 + 32 * jm + 4 * hh;
#pragma unroll
        for (int rq = 0; rq < 4; ++rq) *(GAS f32x4*)(so + 8 * rq) = (f32x4){sacc[4 * rq + 0], sacc[4 * rq + 1], sacc[4 * rq + 2], sacc[4 * rq + 3]}; }
    __syncthreads();
}

__device__ __forceinline__ void conv_fix_block(Frame& F, const Args& a, int blk, __amdgpu_buffer_rsrc_t wsr) {
    unsigned char* ws = a.ws;
    bf16* ACT = (bf16*)(ws + WS_UV); const float* CP = (const float*)(ws + WS_CP); const float* UVS = (const float*)(ws + WS_UVS); const float* UL = (const float*)(ws + WS_UL);
    const float* cw = a.in[27]; float* out = a.out;
    constexpr int CH = DFF / 8;
    int t0 = F.tid; asm volatile("" : "+v"(t0));
    for (int it = t0; it < 2 * CH; it += 512) {
        const int n0 = (it % CH) * 8, rr = it / CH;
        if ((blk & 31) == 31) { const float* u = UL + ((size_t)blk * 2 + rr) * DFF + n0; float* dst = out + O_PCONV + ((size_t)(blk >> 5) * 2 + rr) * DFF + n0;
            *(GAS f32x4*)dst = *(const GAS f32x4*)u; *(GAS f32x4*)(dst + 4) = *(const GAS f32x4*)(u + 4); }
        if ((blk & 31) == 0) continue;
        float c8[8], uv8[8], um1[8], um2[8];
        { const float* p = CP + ((size_t)blk * 2 + rr) * DFF + n0; const f32x4 a0 = *(const GAS f32x4*)p, a1 = *(const GAS f32x4*)(p + 4);
          const float* q = UVS + ((size_t)blk * 2 + rr) * DFF + n0; const f32x4 b0 = *(const GAS f32x4*)q, b1 = *(const GAS f32x4*)(q + 4);
          const float* u1 = UL + ((size_t)(blk - 1) * 2 + 1) * DFF + n0; const f32x4 c0 = *(const GAS f32x4*)u1, c1 = *(const GAS f32x4*)(u1 + 4);
          const float* u2 = UL + ((size_t)(blk - 1) * 2 + 0) * DFF + n0; const f32x4 d0 = *(const GAS f32x4*)u2, d1 = *(const GAS f32x4*)(u2 + 4);
#pragma unroll
          for (int e = 0; e < 4; ++e) { c8[e] = a0[e]; c8[4 + e] = a1[e]; uv8[e] = b0[e]; uv8[4 + e] = b1[e]; um1[e] = c0[e]; um1[4 + e] = c1[e]; um2[e] = d0[e]; um2[4 + e] = d1[e]; } }
        float o8[8];
#pragma unroll
        for (int e = 0; e < 8; ++e) { const int n = n0 + e;
            const float c = c8[e] + (rr == 0 ? cw[n] * um2[e] + cw[DFF + n] * um1[e] : cw[n] * um1[e]);
            const float z = c * (0.7978845608028654f + 0.035677408136300125f * c * c);
            o8[e] = c * __builtin_amdgcn_rcpf(1.0f + __builtin_amdgcn_exp2f(-2.0f * LOG2E * z)) * uv8[e]; }
        pg8::st_wt(wsr, (unsigned)(WS_UV + ((size_t)(blk * 64 + rr) * DFF + n0) * 2), packf8(o8));
    }
}

__device__ __forceinline__ void norm_tile(Frame& F, const Args& a, int pm, int pn, unsigned* pc, LAS float* RST) {
    int t0 = F.tid; asm volatile("" : "+v"(t0));
    const float* SS3 = (const float*)(a.ws + WS_SS3); const bf16* X2 = (const bf16*)(a.ws + WS_BUFA);
    if (t0 < 64) { unsigned sp = 0;
        while ((unsigned)__builtin_amdgcn_readfirstlane(__hip_atomic_load(pc + pm * 32, RLX_AGENT)) < 4u) { __builtin_amdgcn_s_sleep(2); if (++sp > (1u << 22)) { if (t0 == 0) __hip_atomic_store(F.ctl + CW_TMO, 1u, RLX_AGENT); break; } } }
    __syncthreads();
    if (t0 < 256) { const float* sp = SS3 + (size_t)(pm * 256 + t0) * 16; float q = 0.f;
#pragma unroll
        for (int j = 0; j < 16; ++j) q += __hip_atomic_load(sp + j, RLX_AGENT);
        RST[t0] = __builtin_amdgcn_rsqf(q * (1.0f / DM) + 1e-6f); }
    __syncthreads();
    const int c8 = pn * 256 + (t0 & 31) * 8, r0 = t0 >> 5;
    const GAS f32x4* gp = (const GAS f32x4*)(a.in[30] + c8); const f32x4 g0 = gp[0], g1 = gp[1];
#pragma unroll 4
    for (int i = 0; i < 16; ++i) { const int r = r0 + 16 * i; const size_t row = (size_t)pm * 256 + r;
        float x[8]; unpack8(__builtin_nontemporal_load((const GAS v4u*)(X2 + row * DM + c8)), x); const float rs = RST[r];
        GAS f32x4* yr = (GAS f32x4*)(a.out + row * DM + c8);
        __builtin_nontemporal_store((f32x4){x[0], x[1], x[2], x[3]} * rs * g0, &yr[0]); __builtin_nontemporal_store((f32x4){x[4], x[5], x[6], x[7]} * rs * g1, &yr[1]); }
    __syncthreads();
}

__device__ __forceinline__ void final_norm(Frame& F, const Args& a) {
    const float* SS3 = (const float*)(a.ws + WS_SS3); const float* fg = a.in[30]; const bf16* X2 = (const bf16*)(a.ws + WS_BUFA);
    const int gw = F.vcu * NWAVES + F.wave, NGW = F.G * NWAVES;
    f32x4 gv[4];
    { const GAS f32x4* gp = (const GAS f32x4*)fg; gv[0] = gp[2 * F.lane]; gv[1] = gp[2 * F.lane + 1]; gv[2] = gp[128 + 2 * F.lane]; gv[3] = gp[128 + 2 * F.lane + 1]; }
    for (int m = MP + gw; m < M; m += NGW) {
        const GAS v4u* xr = (const GAS v4u*)(X2 + (size_t)m * DM); float x0[8], x1[8]; unpack8(xr[F.lane], x0); unpack8(xr[64 + F.lane], x1);
        const GAS f32x4* sl = (const GAS f32x4*)((const float*)(a.ws + WS_UG) + (size_t)(m - MP) * DM);
#pragma unroll
        for (int z = 0; z < 11; ++z) { const GAS f32x4* p = sl + (size_t)z * 1024 * 256; const f32x4 a0 = p[2 * F.lane], a1 = p[2 * F.lane + 1], a2 = p[128 + 2 * F.lane], a3 = p[128 + 2 * F.lane + 1];
#pragma unroll
            for (int e = 0; e < 4; ++e) { x0[e] += a0[e]; x0[4 + e] += a1[e]; x1[e] += a2[e]; x1[4 + e] += a3[e]; } }
        float q = 0.f;
#pragma unroll
        for (int e = 0; e < 8; ++e) q += x0[e] * x0[e] + x1[e] * x1[e];
        const float rs = 1.0f / sqrtf(wave_sum(q) * (1.0f / DM) + 1e-6f);
        GAS f32x4* yr = (GAS f32x4*)(a.out + (size_t)m * DM);
        yr[2 * F.lane] = (f32x4){x0[0], x0[1], x0[2], x0[3]} * rs * gv[0]; yr[2 * F.lane + 1] = (f32x4){x0[4], x0[5], x0[6], x0[7]} * rs * gv[1];
        yr[128 + 2 * F.lane] = (f32x4){x1[0], x1[1], x1[2], x1[3]} * rs * gv[2]; yr[128 + 2 * F.lane + 1] = (f32x4){x1[4], x1[5], x1[6], x1[7]} * rs * gv[3];
    }
}

__device__ __forceinline__ void sub_barrier(gu32* cnt, gu32* tmo, unsigned n) {
    asm volatile("s_waitcnt vmcnt(0)" ::: "memory"); __syncthreads();
    if (threadIdx.x == 0) {
        __builtin_amdgcn_fence(__ATOMIC_RELEASE, "agent"); asm volatile("s_waitcnt vmcnt(0)" ::: "memory");
        __hip_atomic_fetch_add(cnt, 1u, RLX_AGENT);
        unsigned sp = 0;
        while (__hip_atomic_load(cnt, RLX_AGENT) < n) { __builtin_amdgcn_s_sleep(2); if (++sp > (1u << 22)) { __hip_atomic_store(tmo, 1u, RLX_AGENT); break; } }
        __builtin_amdgcn_fence(__ATOMIC_ACQUIRE, "agent"); asm volatile("s_waitcnt vmcnt(0)" ::: "memory");
    }
    __syncthreads();
}

__global__ void __launch_bounds__(NWAVES * 64, 2) fwd(Args args) {
    extern __shared__ __attribute__((aligned(16))) unsigned char lds[];
    Frame F;
    F.lds = (LAS unsigned char*)lds;
    F.MISC = (volatile LAS unsigned*)(F.lds + MISC_OFF);
    F.tid = threadIdx.x; F.lane = F.tid & 63; F.wave = __builtin_amdgcn_readfirstlane(F.tid >> 6);
    F.G = gridDim.x; { const int bx = blockIdx.x; F.vcu = (F.G % 8 == 0) ? (bx % 8) * (F.G / 8) + bx / 8 : bx; }
    unsigned char* ws = args.ws;
    F.ctl = (gu32*)(ws + WS_CTL);
    for (int u = F.tid; u < (LDS_BYTES - LDSCTL_OFF) / 4; u += NWAVES * 64) ((LAS unsigned*)(F.lds + LDSCTL_OFF))[u] = 0u;
    __syncthreads();
    XcdBarrier bar; bar.bar = (unsigned*)(F.ctl + CW_BAR); bar.x = 0; bar.st = nullptr;
    if (N_LAUNCHES == 1) bar = xcd_barrier_post((unsigned*)(F.ctl + CW_BAR), F.MISC + 8);
#define GRID_BAR() do { if (N_LAUNCHES == 1) xcd_barrier(bar); } while (0)
    const int lo = args.ph_lo, hi = args.ph_hi;
#define IN(k) (lo <= (k) && (k) < hi)
#define BOTH(k) (IN(k) && IN((k) + 1))
    typedef pg8::bf16_t pb;
    if (IN(0)) { p0_prologue(F, args); if (PROBE_DUP == 0) { __syncthreads(); p0_prologue(F, args); } if (BOTH(0)) GRID_BAR(); }
    if (IN(1)) {
        pg8::Gemm g{(const pb*)(ws + WS_BUFA), (const pb*)(ws + WS_WIN), M, INC, DM, DM, DM, 128, 256, 0}; pg8::ProjOrder S; S.init(MP, INC, F.G, (int)blockIdx.x);
        pg8::EpiProj E{(pb*)(ws + WS_QKV), (pb*)(ws + WS_RWB), ws + WS_GA8, ws + WS_GB, (const float*)(ws + WS_RS1)};
        pg8::gemm_phase<pg8::EpiProj, pg8::ProjOrder, true, true>(F.lds + RING_OFF, g, S, E);
        if (BOTH(1)) GRID_BAR();
    }
    if (IN(2)) {
        constexpr int NS = (MS / 256) * (INC / 256), NF = 256 - NS, U0 = 5 * NF;
        const int cb = F.vcu - (F.G - NS);
        if (F.G != 256) { rwkv_prep_mfma(F, args, F.vcu, F.G, M / 32); }
        else if (cb < 0) rwkv_prep_mfma(F, args, F.vcu, NF, U0);
        else {
            { pg8::Gemm g{(const pb*)(ws + WS_BUFA), (const pb*)(ws + WS_WIN), M, INC, DM, DM, DM, 128, 256, 0}; pg8::RangeOrder S; S.init(MP / 256, MS / 256, INC, NS, cb);
              pg8::EpiProj E{(pb*)(ws + WS_QKV), (pb*)(ws + WS_RWB), ws + WS_GA8, ws + WS_GB, (const float*)(ws + WS_RS1)};
              pg8::gemm_phase<pg8::EpiProj, pg8::RangeOrder, true, true>(F.lds + RING_OFF, g, S, E); }
            asm volatile("s_waitcnt vmcnt(0)" ::: "memory"); __syncthreads();
            if (F.tid == 0) { __builtin_amdgcn_fence(__ATOMIC_RELEASE, "agent"); asm volatile("s_waitcnt vmcnt(0)" ::: "memory"); __hip_atomic_fetch_add(F.ctl + CW_SUB + 192, 1u, RLX_AGENT);
                unsigned sp = 0; while (__hip_atomic_load(F.ctl + CW_SUB + 192, RLX_AGENT) < (unsigned)NS) { __builtin_amdgcn_s_sleep(2); if (++sp > (1u << 22)) { __hip_atomic_store(F.ctl + CW_TMO, 1u, RLX_AGENT); break; } }
                __builtin_amdgcn_fence(__ATOMIC_ACQUIRE, "agent"); asm volatile("s_waitcnt vmcnt(0)" ::: "memory"); }
            __syncthreads();
            rwkv_prep_mfma(F, args, U0 + cb, NS, M / 32);
        }
        __syncthreads(); p0_weights(F, args, 1, F.vcu * NWAVES + F.wave, F.G * NWAVES);
        if (BOTH(2)) GRID_BAR();
    }
    if (IN(3)) {
        const int GR = F.G / 2, NO = F.G - GR, o = F.vcu - GR;
        if (F.vcu < GR) { for (int u = F.vcu; u < NB * 8; u += GR) { if (PROBE_DUP == 2) rwkv_chunked<true, PROBE_SKIP>(F, args, u >> 3, u & 7); rwkv_chunked<false>(F, args, u >> 3, u & 7); } }
        else { attn_v1(F, args, o, NO); if (PROBE_DUP == 30) { __syncthreads(); attn_v1(F, args, o, NO); }
            sub_barrier(F.ctl + CW_SUB, F.ctl + CW_TMO, (unsigned)NO);
            { pg8::Gemm g{(const pb*)(ws + WS_ATT), (const pb*)(ws + WS_WPA), M, DM, RW, RW, RW, 128, 256, 0}; pg8::StaticOrder S; S.init(M, DM, NO, o);
              pg8::EpiMix1 E{ws + WS_GA8, (pb*)(ws + WS_GA)};
              pg8::gemm_phase<pg8::EpiMix1, pg8::StaticOrder, true, true>(F.lds + RING_OFF, g, S, E); }
            __syncthreads(); for (int k = o; k < DECB; k += NO) { rwkv_scan_sample(F, args, k); __syncthreads(); } }
        if (BOTH(3)) GRID_BAR();
    }
    if (IN(4)) {
        { pg8::Gemm g{(const pb*)(ws + WS_RWO), (const pb*)(ws + WS_WPB), M, DM, RW, RW, RW, 128, 256, 0}; pg8::StaticOrder S; S.init(M, DM, F.G, (int)blockIdx.x);
          pg8::EpiMix2 E{ws + WS_GB, (const pb*)(ws + WS_GA), (pb*)(ws + WS_GA)};
          pg8::gemm_phase<pg8::EpiMix2, pg8::StaticOrder, true, true>(F.lds + RING_OFF, g, S, E); }
        if ((int)blockIdx.x >= 16) { state_copies(F, args, (int)blockIdx.x - 16, F.G - 16); __syncthreads(); p0_weights(F, args, 2, ((int)blockIdx.x - 16) * NWAVES + F.wave, (F.G - 16) * NWAVES); }
        if (BOTH(4)) GRID_BAR();
    }
    if (IN(5)) {
        pg8::Gemm g{(const pb*)(ws + WS_GA), (const pb*)(ws + WS_WO), M, DM, DM, DM, DM, 128, 256, 0}; pg8::StaticOrder S; S.init(MP, DM, F.G, (int)blockIdx.x);
        pg8::EpiWo E{(pb*)(ws + WS_BUFA), (float*)(ws + WS_SS2)};
        pg8::gemm_phase<pg8::EpiWo, pg8::StaticOrder, true, true>(F.lds + RING_OFF, g, S, E); if (PROBE_DUP == 5) { __syncthreads(); pg8::gemm_phase<pg8::EpiWo, pg8::StaticOrder, true, true>(F.lds + RING_OFF, g, S, E); }
        if (BOTH(5)) GRID_BAR();
    }
    if (IN(6)) {
        const int cs = (int)blockIdx.x - (F.G - 16);
        if (cs >= 0) {
            { pg8::Gemm g{(const pb*)(ws + WS_GA), (const pb*)(ws + WS_WO), M, DM, DM, DM, DM, 128, 256, 0}; pg8::RangeOrder S; S.init(MP / 256, MS / 256, DM, 16, cs);
              pg8::EpiWo E{(pb*)(ws + WS_BUFA), (float*)(ws + WS_SS2)};
              pg8::gemm_phase<pg8::EpiWo, pg8::RangeOrder, true, true>(F.lds + RING_OFF, g, S, E); }
            asm volatile("s_waitcnt vmcnt(0)" ::: "memory"); __syncthreads();
            if (F.tid == 0) { __builtin_amdgcn_fence(__ATOMIC_RELEASE, "agent"); asm volatile("s_waitcnt vmcnt(0)" ::: "memory"); __hip_atomic_fetch_add(F.ctl + CW_SUB + 64, 1u, RLX_AGENT); }
            __syncthreads();
        }
#define DF_IDS() int c = (int)blockIdx.x; asm volatile("" : "+s"(c)); const int x = c & 7, w = c >> 3; const bool late = c >= F.G - 16, busy = c < 88, idle = !late && !busy; (void)x; (void)w; (void)late; (void)busy; (void)idle; \
        unsigned* tmo = (unsigned*)(F.ctl + CW_TMO); (void)tmo
#define DF_CNT(k) ((unsigned*)(F.ctl + CW_DF + (k) * 32))
        const __amdgpu_buffer_rsrc_t wsr = __builtin_amdgcn_make_buffer_rsrc(ws, 0, (int)WS_END, 0x00020000);
        {
            DF_IDS(); const unsigned nA = (w < 16) ? 6u : 5u;
            pg8::Gemm g{(const pb*)(ws + WS_BUFA), (const pb*)(ws + WS_WUP), M, 2 * DFF, DM, DM, DM, DFF, 128, 0};
            pg8::UpOrder S; S.so.init(MP, 2 * DFF, F.G, c); S.mode = 0; S.spm = 0; S.spn = 0; S.wcnt = nullptr; S.wneed = 0u; S.tmo = tmo;
            S.pub_round = late ? (int)nA - 1 : -2; S.pub_n = nA; S.pub_cnt = DF_CNT(2 * x);
            LAS float* RSL = (LAS float*)(F.lds + RING_BYTES);
            { pg8::Unit u; const float* ss2 = (const float*)(ws + WS_SS2); const int r = F.tid & 255;
              for (int i = F.tid >> 8; S.next(i, u); i += 2) { const GAS f32x4* sp = (const GAS f32x4*)(ss2 + (size_t)(u.pm * 256 + r) * 16);
                  const f32x4 s0 = sp[0], s1 = sp[1], s2 = sp[2], s3 = sp[3]; const f32x4 st = (s0 + s1) + (s2 + s3);
                  RSL[i * 256 + r] = __builtin_amdgcn_rsqf(((st[0] + st[1]) + (st[2] + st[3])) * (1.0f / 1024.0f) + 1e-6f); }
              __syncthreads(); }
            pg8::EpiUpAct E{(pb*)(ws + WS_UV), (const float*)(ws + WS_SS2), args.in[27], args.in[28], args.in[6], (float*)(ws + WS_CP), (float*)(ws + WS_UVS), (float*)(ws + WS_UL), args.out + O_SCONV, MP, wsr, (unsigned)WS_UV, (unsigned)WS_CP, (unsigned)WS_UVS, (unsigned)WS_UL, (const PG8_LAS float*)RSL};
            pg8::gemm_phase<pg8::EpiUpAct, pg8::UpOrder, true, true>(F.lds + RING_OFF, g, S, E);
        }
        {
            DF_IDS(); const unsigned nA = (w < 16) ? 6u : 5u;
            pg8::wg_publish_wt(DF_CNT(2 * x), late ? 0u : nA, DF_CNT(2 * x + 1), 11u - nA);
            if (!late) {
                pg8::wg_wait(DF_CNT(2 * x), 176u, tmo);
                conv_fix_block(F, args, 64 * x + w + 1, wsr); if (w == 0) conv_fix_block(F, args, 64 * x + 31, wsr);
                pg8::wg_publish_wt(DF_CNT(16 + 2 * x), 1u, nullptr, 0u);
            }
            if (busy) {
                pg8::Gemm g{(const pb*)(ws + WS_BUFA), (const pb*)(ws + WS_WUP), M, 2 * DFF, DM, DM, DM, DFF, 128, 0};
                pg8::UpOrder S; S.so.init(MP, 2 * DFF, F.G, c); S.mode = 1; S.spm = MP / 256 + c / 22; S.spn = c % 22; S.wcnt = (unsigned*)(F.ctl + CW_SUB + 64); S.wneed = 16u; S.tmo = tmo; S.pub_round = -2; S.pub_n = 0u; S.pub_cnt = nullptr;
                pg8::EpiUpAct E{(pb*)(ws + WS_UV), (const float*)(ws + WS_SS2), args.in[27], args.in[28], args.in[6], (float*)(ws + WS_CP), (float*)(ws + WS_UVS), (float*)(ws + WS_UL), args.out + O_SCONV, MP, wsr, (unsigned)WS_UV, (unsigned)WS_CP, (unsigned)WS_UVS, (unsigned)WS_UL, (const PG8_LAS float*)(F.lds + RING_BYTES)};
                pg8::gemm_phase<pg8::EpiUpAct, pg8::UpOrder, true, true>(F.lds + RING_OFF, g, S, E);
                pg8::wg_publish(DF_CNT(32), 1u, nullptr, 0u);
            }
        }
#define DF_DOWN(I0, I1) do { DF_IDS(); \
            pg8::Gemm g{(const pb*)(ws + WS_UV), (const pb*)(ws + WS_WDN), M, DM, DFF, DFF, DFF, 128, 256, DFF / 11};        \
            pg8::DownOrder D; D.so.init(MP, DM, F.G, c); D.i0 = (I0); D.i1 = (I1); D.j0 = idle ? c - 88 : -1; D.j1 = (idle && c - 88 < 24) ? c - 88 + 152 : -1; \
            D.w0 = DF_CNT(16 + 2 * x); D.n0 = 30u; D.w1 = DF_CNT(17 + 2 * x); D.n1 = 19u; D.w2 = DF_CNT(32); D.n2 = 88u; D.tmo = tmo; D.pc = DF_CNT(33); \
            pg8::EpiDown E{(pb*)(ws + WS_BUFA), (float*)(ws + WS_SS3), (float*)(ws + WS_UG), MP}; \
            pg8::gemm_phase<pg8::EpiDown, pg8::DownOrder, true, true>(F.lds + RING_OFF, g, D, E); } while (0)
        DF_DOWN(0, 1);
        {
            DF_IDS();
            if (idle) {
                pg8::wg_wait(DF_CNT(2 * x + 1), 176u, tmo);
                const int k = w - 11; conv_fix_block(F, args, 64 * x + 32 + k + 1, wsr); if (k <= 11) conv_fix_block(F, args, 64 * x + 32 + k + 20, wsr);
                pg8::wg_publish_wt(DF_CNT(17 + 2 * x), 1u, nullptr, 0u);
            }
        }
        DF_DOWN(1, 4);
        {
            DF_IDS(); pg8::StaticOrder so; so.init(MP, DM, F.G, c); pg8::Unit u; LAS float* RST = (LAS float*)(F.lds + RING_BYTES + 12288);
            so.next(0, u); norm_tile(F, args, u.pm, u.pn, DF_CNT(33), RST);
            so.next(1, u); norm_tile(F, args, u.pm, u.pn, DF_CNT(33), RST);
        }
#undef DF_DOWN
#undef DF_CNT
#undef DF_IDS
        if (BOTH(6)) GRID_BAR();
    }
    if (IN(9)) { final_norm(F, args); if (PROBE_DUP == 9) { __syncthreads(); final_norm(F, args); } }
#undef IN
#undef BOTH
}

extern "C" void kernel_launch(void* const* d_in, const int* in_sizes, int n_in, void* d_out, int out_size, void* d_ws, size_t ws_size, hipStream_t stream) {
    static int grid = 0;
    if (grid == 0) {
        if (n_in != 31 || out_size != 45109248 || ws_size < WS_END) { fprintf(stderr, "kernel_launch: unexpected shapes n_in %d out %d ws %zu\n", n_in, out_size, ws_size); grid = -1; return; }
        int dev = 0, cus = 0, per_cu = 0;
        if (hipGetDevice(&dev) != hipSuccess || hipDeviceGetAttribute(&cus, hipDeviceAttributeMultiprocessorCount, dev) != hipSuccess) { grid = -1; return; }
        if (hipFuncSetAttribute((const void*)fwd, hipFuncAttributeMaxDynamicSharedMemorySize, LDS_BYTES) != hipSuccess) { fprintf(stderr, "kernel_launch: hipFuncSetAttribute failed\n"); grid = -1; return; }
        if (hipOccupancyMaxActiveBlocksPerMultiprocessor(&per_cu, (const void*)fwd, NWAVES * 64, LDS_BYTES) != hipSuccess || per_cu < 1) fprintf(stderr, "kernel_launch: occupancy query says %d\n", per_cu);
        (void)hipGetLastError();
        grid = cus;
    }
    if (grid < 0) return;
    (void)hipMemsetAsync((char*)d_ws + WS_CTL, 0, CTL_ZERO_BYTES, stream);
    Args a{};
    for (int i = 0; i < 31; ++i) a.in[i] = (const float*)d_in[i];
    a.out = (float*)d_out; a.ws = (unsigned char*)d_ws;
    if (N_LAUNCHES == 1) { a.ph_lo = 0; a.ph_hi = NPH; a.li = 0; hipLaunchKernelGGL(fwd, dim3(grid), dim3(NWAVES * 64), LDS_BYTES, stream, a); }
    else { for (int li = 0; li < NPH; ++li) { a.ph_lo = li; a.ph_hi = li + 1; a.li = li; hipLaunchKernelGGL(fwd, dim3(grid), dim3(NWAVES * 64), LDS_BYTES, stream, a); } }
}
```
